# Optimizing an MI355X kernel written in HIP

```python
import math
import jax, jax.numpy as jnp
from jax import lax
import numpy as np

D_MODEL = 1024
BATCH = 16
SEQ = 2048
DEPTH = 1

A_HEADS = 8
A_HEAD_DIM = 64
IDX_HEADS = 8
IDX_DIM = 64
TOPK_MAX = 256
Q_BLOCK = 128
ROPE_THETA = 10000.0
B_HEADS = 4
B_KEY_DIM = 128
B_VAL_DIM = 128
CONV_WIDTH = 4
CHUNK = 64
D_FF = 2816
MACARON_WEIGHT = 0.5
DEEPNORM_ALPHA = (2.0 * DEPTH) ** 0.25
DEEPNORM_BETA = (8.0 * DEPTH) ** -0.25
LN_EPS = 1e-5
RMS_EPS = 1e-6
N_MOD = 9

MIX_WIDTH = A_HEADS * A_HEAD_DIM + B_HEADS * B_VAL_DIM
IN_SPLITS = (A_HEADS * A_HEAD_DIM, A_HEAD_DIM, A_HEAD_DIM,
             IDX_HEADS * IDX_DIM, IDX_DIM, IDX_HEADS,
             B_HEADS * B_KEY_DIM, B_HEADS * B_KEY_DIM, B_HEADS * B_VAL_DIM,
             B_HEADS * B_VAL_DIM, B_HEADS, B_HEADS)
IN_WIDTH = sum(IN_SPLITS)
CONV_CH = 2 * B_HEADS * B_KEY_DIM + B_HEADS * B_VAL_DIM

kernel_name = "hymba_dsa_gdn_macaron_deepnorm_adaln"


def layer_norm(x, g, b):
    xf = x.astype(jnp.float32)
    mu = jnp.mean(xf, axis=-1, keepdims=True)
    var = jnp.mean(jnp.square(xf - mu), axis=-1, keepdims=True)
    return ((xf - mu) * lax.rsqrt(var + LN_EPS) * g + b).astype(x.dtype)


def rms_norm(x, g):
    xf = x.astype(jnp.float32)
    return xf * lax.rsqrt(jnp.mean(jnp.square(xf), axis=-1, keepdims=True) + RMS_EPS) * g


def l2norm(t):
    tf = t.astype(jnp.float32)
    return tf * lax.rsqrt(jnp.sum(jnp.square(tf), axis=-1, keepdims=True) + RMS_EPS)


def modulate(x, shift, scale):
    return x * (1.0 + scale) + shift


def swiglu_ffn(u, w1, w3, w2):
    return (jax.nn.silu(u @ w1) * (u @ w3)) @ w2


def rope(t, positions):
    d = t.shape[-1]
    inv_freq = ROPE_THETA ** (-jnp.arange(0, d, 2, dtype=jnp.float32) / d)
    ang = positions.astype(jnp.float32)[..., None] * inv_freq
    cos = jnp.cos(ang)[:, :, None, :]
    sin = jnp.sin(ang)[:, :, None, :]
    tf = t.astype(jnp.float32)
    t1, t2 = tf[..., : d // 2], tf[..., d // 2:]
    return jnp.concatenate([t1 * cos - t2 * sin, t2 * cos + t1 * sin], axis=-1).astype(t.dtype)


def dsa_sparse_attention(q, k, v, q_idx, k_idx, w_idx):
    bsz, seq = q.shape[0], q.shape[1]
    n_sel = min(TOPK_MAX, seq // 4)
    nblk = seq // Q_BLOCK
    key_pos = jnp.arange(seq)
    b_idx = jnp.arange(bsz)[:, None, None]

    def to_blocks(t):
        return jnp.moveaxis(t.reshape((bsz, nblk, Q_BLOCK) + t.shape[2:]), 1, 0)

    def block(args):
        blk, qb, qib, wib = args
        q_pos = blk * Q_BLOCK + jnp.arange(Q_BLOCK)
        causal = key_pos[None, :] <= q_pos[:, None]
        rel = jax.nn.relu(jnp.einsum('bqhd,bsd->bqhs', qib, k_idx))
        score = jnp.einsum('bqh,bqhs->bqs', wib, rel).astype(jnp.float32)
        score = jnp.where(causal[None], score, -jnp.inf)
        _, sel = lax.top_k(score, n_sel)
        valid = sel <= q_pos[None, :, None]
        k_sel = k[b_idx, sel]
        v_sel = v[b_idx, sel]
        logits = jnp.einsum('bqhd,bqnd->bqhn', qb, k_sel).astype(jnp.float32) * (A_HEAD_DIM ** -0.5)
        logits = jnp.where(valid[:, :, None, :], logits, -jnp.inf)
        p = jax.nn.softmax(logits, axis=-1).astype(v.dtype)
        return jnp.einsum('bqhn,bqnd->bqhd', p, v_sel)

    out = lax.map(block, (jnp.arange(nblk), to_blocks(q), to_blocks(q_idx), to_blocks(w_idx)))
    return jnp.moveaxis(out, 0, 1).reshape(bsz, seq, A_HEADS * A_HEAD_DIM)


def causal_short_conv(u, w):
    n_ch = u.shape[-1]
    return lax.conv_general_dilated(u, w[:, None, :].astype(u.dtype), window_strides=(1,),
                                    padding=[(CONV_WIDTH - 1, 0)],
                                    dimension_numbers=('NWC', 'WIO', 'NWC'),
                                    feature_group_count=n_ch)


def gated_delta_rule_chunked(q, k, v, log_a, beta):
    bsz, seq, nh, dk = q.shape
    dv = v.shape[-1]
    nc = seq // CHUNK

    def chunks(t):
        t = t.astype(jnp.float32).reshape((bsz, nc, CHUNK, nh) + t.shape[3:])
        return jnp.moveaxis(t, 3, 1)

    q, k, v, log_a, beta = (chunks(t) for t in (q, k, v, log_a, beta))
    q = q * (dk ** -0.5)
    gam = jnp.cumsum(log_a, axis=-1)
    diff = gam[..., :, None] - gam[..., None, :]
    strict = jnp.tril(jnp.ones((CHUNK, CHUNK), dtype=bool), -1)
    incl = jnp.tril(jnp.ones((CHUNK, CHUNK), dtype=bool))
    dec_strict = jnp.where(strict, jnp.exp(jnp.where(strict, diff, 0.0)), 0.0)
    dec_incl = jnp.where(incl, jnp.exp(jnp.where(incl, diff, 0.0)), 0.0)
    g_cum = jnp.exp(gam)
    lower = beta[..., :, None] * jnp.einsum('bhnid,bhnjd->bhnij', k, k) * dec_strict
    t_mat = lower + jnp.eye(CHUNK, dtype=jnp.float32)
    w = lax.linalg.triangular_solve(t_mat, (beta * g_cum)[..., None] * k,
                                    left_side=True, lower=True, unit_diagonal=True)
    u = lax.linalg.triangular_solve(t_mat, beta[..., None] * v,
                                    left_side=True, lower=True, unit_diagonal=True)
    a_qk = jnp.einsum('bhnid,bhnjd->bhnij', q, k) * dec_incl
    q_dec = q * g_cum[..., None]
    k_dec = k * jnp.exp(gam[..., -1:] - gam)[..., None]
    g_last = g_cum[..., -1]

    def step(state, xs):
        w_c, u_c, aqk_c, qd_c, kd_c, gl_c = xs
        delta = u_c - w_c @ state
        out = qd_c @ state + aqk_c @ delta
        state = gl_c[..., None, None] * state + jnp.swapaxes(kd_c, -1, -2) @ delta
        return state, out

    xs = tuple(jnp.moveaxis(t, 2, 0) for t in (w, u, a_qk, q_dec, k_dec, g_last))
    state0 = jnp.zeros((bsz, nh, dk, dv), jnp.float32)
    _, out = lax.scan(step, state0, xs)
    out = jnp.moveaxis(out, 0, 2)
    return jnp.moveaxis(out, 1, 3).reshape(bsz, seq, nh, dv)


def hybrid_mixer(u, positions, w_in, conv_w, a_log, dt_bias, dn_norm_g, w_out):
    bsz, seq, _ = u.shape
    split_points = tuple(int(s) for s in np.cumsum(IN_SPLITS)[:-1])
    proj = u @ w_in
    a_q, a_k, a_v, i_q, i_k, i_w, b_q, b_k, b_v, b_z, b_a, b_b = jnp.split(proj, split_points, axis=-1)

    q = rope(a_q.reshape(bsz, seq, A_HEADS, A_HEAD_DIM), positions)
    k = rope(a_k[:, :, None, :], positions)[:, :, 0]
    qi = rope(i_q.reshape(bsz, seq, IDX_HEADS, IDX_DIM), positions)
    ki = rope(i_k[:, :, None, :], positions)[:, :, 0]
    wi = i_w * (IDX_HEADS ** -0.5 * IDX_DIM ** -0.5)
    attn_out = dsa_sparse_attention(q, k, a_v, qi, ki, wi)

    qkv = jax.nn.silu(causal_short_conv(jnp.concatenate([b_q, b_k, b_v], axis=-1), conv_w))
    dq, dk_, dv_ = jnp.split(qkv, (B_HEADS * B_KEY_DIM, 2 * B_HEADS * B_KEY_DIM), axis=-1)
    dq = l2norm(dq.reshape(bsz, seq, B_HEADS, B_KEY_DIM))
    dk_ = l2norm(dk_.reshape(bsz, seq, B_HEADS, B_KEY_DIM))
    dv_ = dv_.reshape(bsz, seq, B_HEADS, B_VAL_DIM)
    log_a = -jnp.exp(a_log.astype(jnp.float32)) * jax.nn.softplus((b_a + dt_bias).astype(jnp.float32))
    beta = jax.nn.sigmoid(b_b.astype(jnp.float32))
    dn = gated_delta_rule_chunked(dq, dk_, dv_, log_a, beta)
    gate = jax.nn.silu(b_z.reshape(bsz, seq, B_HEADS, B_VAL_DIM).astype(jnp.float32))
    dn_out = (rms_norm(dn, dn_norm_g) * gate).astype(u.dtype).reshape(bsz, seq, B_HEADS * B_VAL_DIM)

    return jnp.concatenate([attn_out, dn_out], axis=-1) @ w_out


def setup_inputs(seed: int = 0) -> dict:
    key = jax.random.key(seed)
    ks = jax.random.split(key, 24)
    D = D_MODEL

    def nrm(k, shape, scale):
        return jax.random.normal(k, shape, jnp.float32) * scale

    x = nrm(ks[0], (BATCH, SEQ, D), 1.0)
    c = nrm(ks[1], (BATCH, D), 1.0)
    positions = (jnp.arange(SEQ, dtype=jnp.int32)[None, :]
                 + jax.random.randint(ks[2], (BATCH, 1), 0, 64, dtype=jnp.int32))
    w_ada = nrm(ks[3], (DEPTH, D, N_MOD * D), 0.5 * D ** -0.5)
    b_ada = nrm(ks[4], (DEPTH, N_MOD * D), 0.02)
    ffn1_w1 = nrm(ks[5], (DEPTH, D, D_FF), D ** -0.5)
    ffn1_w3 = nrm(ks[6], (DEPTH, D, D_FF), D ** -0.5)
    ffn1_w2 = nrm(ks[7], (DEPTH, D_FF, D), DEEPNORM_BETA * D_FF ** -0.5)
    ln1_g = 1.0 + nrm(ks[8], (DEPTH, D), 0.02)
    ln1_b = nrm(ks[9], (DEPTH, D), 0.02)
    w_in = nrm(ks[10], (DEPTH, D, IN_WIDTH), D ** -0.5)
    conv_w = nrm(ks[11], (DEPTH, CONV_WIDTH, CONV_CH), CONV_WIDTH ** -0.5)
    a_log = jnp.log(jax.random.uniform(ks[12], (DEPTH, B_HEADS), jnp.float32, 1.0, 16.0))
    dt = jnp.exp(jax.random.uniform(ks[13], (DEPTH, B_HEADS), jnp.float32,
                                    math.log(1e-3), math.log(1e-1)))
    dt_bias = dt + jnp.log(-jnp.expm1(-dt))
    dn_norm_g = 1.0 + nrm(ks[14], (DEPTH, B_VAL_DIM), 0.02)
    w_out = nrm(ks[15], (DEPTH, MIX_WIDTH, D), DEEPNORM_BETA * MIX_WIDTH ** -0.5)
    ln2_g = 1.0 + nrm(ks[16], (DEPTH, D), 0.02)
    ln2_b = nrm(ks[17], (DEPTH, D), 0.02)
    ffn2_w1 = nrm(ks[18], (DEPTH, D, D_FF), D ** -0.5)
    ffn2_w3 = nrm(ks[19], (DEPTH, D, D_FF), D ** -0.5)
    ffn2_w2 = nrm(ks[20], (DEPTH, D_FF, D), DEEPNORM_BETA * D_FF ** -0.5)
    ln3_g = 1.0 + nrm(ks[21], (DEPTH, D), 0.02)
    ln3_b = nrm(ks[22], (DEPTH, D), 0.02)
    return {'x': x, 'c': c, 'positions': positions, 'w_ada': w_ada, 'b_ada': b_ada,
            'ffn1_w1': ffn1_w1, 'ffn1_w3': ffn1_w3, 'ffn1_w2': ffn1_w2, 'ln1_g': ln1_g, 'ln1_b': ln1_b,
            'w_in': w_in, 'conv_w': conv_w, 'a_log': a_log, 'dt_bias': dt_bias, 'dn_norm_g': dn_norm_g,
            'w_out': w_out, 'ln2_g': ln2_g, 'ln2_b': ln2_b,
            'ffn2_w1': ffn2_w1, 'ffn2_w3': ffn2_w3, 'ffn2_w2': ffn2_w2, 'ln3_g': ln3_g, 'ln3_b': ln3_b}


def reference(x, c, positions, w_ada, b_ada, ffn1_w1, ffn1_w3, ffn1_w2, ln1_g, ln1_b,
              w_in, conv_w, a_log, dt_bias, dn_norm_g, w_out, ln2_g, ln2_b,
              ffn2_w1, ffn2_w3, ffn2_w2, ln3_g, ln3_b):
    for layer in range(DEPTH):
        mod = (jax.nn.silu(c) @ w_ada[layer] + b_ada[layer])[:, None, :]
        sh1, sc1, g1, sh2, sc2, g2, sh3, sc3, g3 = jnp.split(mod, N_MOD, axis=-1)
        h = swiglu_ffn(modulate(x, sh1, sc1), ffn1_w1[layer], ffn1_w3[layer], ffn1_w2[layer])
        x = layer_norm(DEEPNORM_ALPHA * x + MACARON_WEIGHT * g1 * h, ln1_g[layer], ln1_b[layer])
        h = hybrid_mixer(modulate(x, sh2, sc2), positions, w_in[layer], conv_w[layer], a_log[layer],
                         dt_bias[layer], dn_norm_g[layer], w_out[layer])
        x = layer_norm(DEEPNORM_ALPHA * x + g2 * h, ln2_g[layer], ln2_b[layer])
        h = swiglu_ffn(modulate(x, sh3, sc3), ffn2_w1[layer], ffn2_w3[layer], ffn2_w2[layer])
        x = layer_norm(DEEPNORM_ALPHA * x + MACARON_WEIGHT * g3 * h, ln3_g[layer], ln3_b[layer])
    return x
```

```cpp
#define MIXER 1
#include <hip/hip_runtime.h>
#include <hip/hip_cooperative_groups.h>
#include <cstdio>
#include <cstdint>
namespace pg8 {
#define PG8_LAS __attribute__((address_space(3)))
typedef unsigned short bf16_t;
typedef short bf16x8 __attribute__((ext_vector_type(8)));
typedef float f32x4 __attribute__((ext_vector_type(4)));
typedef unsigned u32x4 __attribute__((ext_vector_type(4)));
constexpr int BM = 256, BK = 64, HALF = 128, HTB = HALF * BK * 2  , STAGE_BYTES = 8 * HTB, NXCD = 8, WGM = 8;

__host__ __device__ __forceinline__ int lds_byte(int r, int c) { const int st = (r >> 4) * 2 + (c >> 5), rr = r & 15, cc = c & 31, ob = rr * 64 + cc * 2; return st * 1024 + (ob ^ (((ob >> 9) & 1) << 5)); }
__host__ __device__ __forceinline__ void stage_rc(int b, int& R, int& C) { const int st = b / 1024, sb = b % 1024, swz = sb ^ (((sb >> 9) & 1) << 5); R = (st >> 1) * 16 + swz / 64; C = (st & 1) * 32 + (swz % 64) / 2; }
__host__ __device__ __forceinline__ int perm32(int rho) { const int n = rho >> 4, i = rho & 15; return 8 * (i >> 2) + 4 * n + (i & 3); }

struct Unit { int pm, pn; };
struct Gemm { const bf16_t* A; const bf16_t* Bt; int M, N, K; };

struct StaticOrder {
    int nM, nN, nwg, G, c;
    __host__ __device__ void init(int M, int N, int G_, int c_) { nM = M / BM; nN = N / BM; nwg = nM * nN; G = G_; c = c_; }
    __host__ __device__ bool next(int i, Unit& u) const {
        const long L = (long)i * G + c; if (L >= nwg) return false;
        int wgid = (int)L; { const int q = nwg / NXCD, r = nwg % NXCD, xcd = wgid % NXCD, off = wgid / NXCD; wgid = (xcd < r ? xcd * (q + 1) : r * (q + 1) + (xcd - r) * q) + off; }
        const int nig = WGM * nN, gid = wgid / nig, fm = gid * WGM, gsz = (nM - fm) < WGM ? (nM - fm) : WGM;
        u.pm = fm + ((wgid % nig) % gsz); u.pn = (wgid % nig) / gsz; return true;
    }
    __device__ __forceinline__ void a_ready(const Unit&) const {}
    __device__ __forceinline__ void done(const Unit&) const {}
};

__device__ __forceinline__ unsigned cvt_pk_bf16(float lo, float hi) { unsigned r; asm volatile("v_cvt_pk_bf16_f32 %0, %1, %2" : "=v"(r) : "v"(lo), "v"(hi)); return r; }
template <class Epi, class Sched, bool ALIGN_EPI = false, bool SP2 = false>
__device__ __forceinline__ void gemm_phase(PG8_LAS unsigned char* lds, const Gemm g, const Sched& S, const Epi& E) {
    int tid_ = threadIdx.x; asm volatile("" : "+v"(tid_));
    const int tid = tid_, wid = __builtin_amdgcn_readfirstlane(tid >> 6), lane = tid & 63, wr = wid >> 2, wc = wid & 3, fr = lane & 15, fq = lane >> 4;
    const int K = g.K, nt = K / BK;
    unsigned voffA[2], voffB[2];
#pragma unroll
    for (int i = 0; i < 2; ++i) { int R, C; stage_rc(tid * 16 + i * 8192, R, C); const int Rb = Epi::PERM ? ((R & ~31) + perm32(R & 31)) : R;
        voffA[i] = (unsigned)(R * K + C) * 2u; voffB[i] = (unsigned)(Rb * K + C) * 2u; }
    const size_t kstep = (size_t)(BK * 2);
    const size_t hstep = (size_t)HALF * K * 2;
    const size_t tstep = 2 * hstep;
    const unsigned ldsw = (unsigned)wid * 1024u;
    const int aoff = lds_byte(wr * 64 + fr, fq * 8), boff = lds_byte(wc * 32 + fr, fq * 8);
#define PG8_SA(b, h) (((b) * 2 + (h)) * HTB)
#define PG8_SB(b, h) ((4 + (b) * 2 + (h)) * HTB)
#define PG8_STAGE(bufoff, gbase, voff) do { _Pragma("unroll") for (int _i = 0; _i < 2; ++_i) \
        __builtin_amdgcn_global_load_lds((const unsigned*)((const char*)(gbase) + (voff)[_i]), (PG8_LAS unsigned*)(lds + (bufoff) + ldsw + _i * 8192), 16, 0, 0); } while (0)
#define PG8_LDA(dst, b, h) do { _Pragma("unroll") for (int m = 0; m < 4; ++m) _Pragma("unroll") for (int k = 0; k < 2; ++k) dst[m][k] = *(const PG8_LAS bf16x8*)(lds + PG8_SA(b, h) + aoff + m * 2048 + k * 1024); } while (0)
#define PG8_LDB(dst, b, h) do { _Pragma("unroll") for (int n = 0; n < 2; ++n) _Pragma("unroll") for (int k = 0; k < 2; ++k) dst[n][k] = *(const PG8_LAS bf16x8*)(lds + PG8_SB(b, h) + boff + n * 2048 + k * 1024); } while (0)
#define PG8_MMA(ai, bj, At, Bt) do { __builtin_amdgcn_s_setprio(1); _Pragma("unroll") for (int m = 0; m < 4; ++m) _Pragma("unroll") for (int n = 0; n < 2; ++n) _Pragma("unroll") for (int k = 0; k < 2; ++k) \
        acc[ai][bj][m][n] = __builtin_amdgcn_mfma_f32_16x16x32_bf16(Bt[n][k], At[m][k], acc[ai][bj][m][n], 0, 0, 0); __builtin_amdgcn_s_setprio(0); } while (0)
#define PG8_WAIT_V(n) asm volatile("s_waitcnt vmcnt(" #n ")" ::: "memory")
#define PG8_WAIT_L(n) asm volatile("s_waitcnt lgkmcnt(" #n ")" ::: "memory")
#define PG8_BAR __builtin_amdgcn_s_barrier()
#define PG8_SCHED __builtin_amdgcn_sched_barrier(0)
    Unit cur, nxt; int ui = 0;
    if (!S.next(0, cur)) return;
    f32x4 acc[2][2][4][2];
#pragma unroll
    for (int a = 0; a < 2; ++a)
#pragma unroll
        for (int b = 0; b < 2; ++b)
#pragma unroll
            for (int m = 0; m < 4; ++m)
#pragma unroll
                for (int n = 0; n < 2; ++n) acc[a][b][m][n] = (f32x4){0.f, 0.f, 0.f, 0.f};
    bf16x8 At[4][2], B0[2][2], B1[2][2];
    const char* cA = (const char*)g.A + (size_t)cur.pm * tstep; const char* cB = (const char*)g.Bt + (size_t)cur.pn * tstep;
    S.a_ready(cur);
    if constexpr (SP2) {
        PG8_STAGE(PG8_SB(0, 0), cB, voffB); PG8_STAGE(PG8_SB(0, 1), cB + hstep, voffB); PG8_STAGE(PG8_SA(0, 0), cA, voffA); PG8_STAGE(PG8_SA(0, 1), cA + hstep, voffA);
        if (wr == 1) PG8_BAR;
        PG8_WAIT_V(2); PG8_BAR;
        PG8_STAGE(PG8_SB(1, 0), cB + kstep, voffB); PG8_STAGE(PG8_SA(1, 0), cA + kstep, voffA); PG8_STAGE(PG8_SB(1, 1), cB + hstep + kstep, voffB);
        PG8_WAIT_V(6); PG8_BAR;
    } else {
        PG8_STAGE(PG8_SB(0, 0), cB, voffB); PG8_STAGE(PG8_SA(0, 0), cA, voffA); PG8_STAGE(PG8_SB(0, 1), cB + hstep, voffB); PG8_STAGE(PG8_SA(0, 1), cA + hstep, voffA);
        if (wr == 1) PG8_BAR;
        PG8_WAIT_V(4); PG8_BAR;
        PG8_STAGE(PG8_SB(1, 0), cB + kstep, voffB); PG8_STAGE(PG8_SA(1, 0), cA + kstep, voffA); PG8_STAGE(PG8_SB(1, 1), cB + hstep + kstep, voffB);
        PG8_WAIT_V(6); PG8_BAR;
    }
    for (;;) {
        const bool has_next = S.next(ui + 1, nxt);
        const char* nA = has_next ? (const char*)g.A + (size_t)nxt.pm * tstep : cA; const char* nB = has_next ? (const char*)g.Bt + (size_t)nxt.pn * tstep : cB;
        for (int t = 0; t < nt; t += 2) {
            const bool last = (t == nt - 2);
            const char* a1 = cA + (size_t)(t + 1) * kstep;
            const char* a2 = last ? nA : cA + (size_t)(t + 2) * kstep; const char* b2 = last ? nB : cB + (size_t)(t + 2) * kstep;
            const char* a3 = a2 + kstep; const char* b3 = b2 + kstep;
            if (last && has_next) S.a_ready(nxt);
            if constexpr (SP2) {
            PG8_LDB(B0, 0, 0); PG8_LDB(B1, 0, 1); PG8_SCHED; PG8_LDA(At, 0, 0); PG8_STAGE(PG8_SA(1, 1), a1 + hstep, voffA);
            PG8_WAIT_V(8); PG8_WAIT_L(0); PG8_BAR; PG8_MMA(0, 0, At, B0); PG8_MMA(0, 1, At, B1); PG8_BAR; PG8_SCHED;
            PG8_LDA(At, 0, 1); PG8_STAGE(PG8_SB(0, 0), b2, voffB); PG8_STAGE(PG8_SB(0, 1), b2 + hstep, voffB); PG8_STAGE(PG8_SA(0, 0), a2, voffA);
            PG8_WAIT_V(8); PG8_WAIT_L(0); PG8_BAR; PG8_MMA(1, 0, At, B0); PG8_MMA(1, 1, At, B1); PG8_BAR; PG8_SCHED;
            PG8_LDB(B0, 1, 0); PG8_LDB(B1, 1, 1); PG8_SCHED; PG8_LDA(At, 1, 0); PG8_STAGE(PG8_SA(0, 1), a2 + hstep, voffA);
            PG8_WAIT_V(8); PG8_WAIT_L(0); PG8_BAR; PG8_MMA(0, 0, At, B0); PG8_MMA(0, 1, At, B1); PG8_BAR; PG8_SCHED;
            PG8_LDA(At, 1, 1); PG8_STAGE(PG8_SB(1, 0), b3, voffB); PG8_STAGE(PG8_SB(1, 1), b3 + hstep, voffB); PG8_STAGE(PG8_SA(1, 0), a3, voffA);
            PG8_WAIT_V(8); PG8_WAIT_L(0); PG8_BAR; PG8_MMA(1, 0, At, B0); PG8_MMA(1, 1, At, B1); PG8_BAR; PG8_SCHED;
            } else {
            PG8_LDB(B0, 0, 0); PG8_SCHED; PG8_LDA(At, 0, 0); PG8_STAGE(PG8_SA(1, 1), a1 + hstep, voffA);
            PG8_WAIT_L(8); PG8_BAR; PG8_WAIT_L(0); PG8_MMA(0, 0, At, B0); PG8_BAR; PG8_SCHED;
            PG8_LDB(B1, 0, 1); PG8_STAGE(PG8_SB(0, 0), b2, voffB);
            PG8_BAR; PG8_WAIT_L(0); PG8_MMA(0, 1, At, B1); PG8_BAR;
            PG8_LDA(At, 0, 1); PG8_STAGE(PG8_SA(0, 0), a2, voffA);
            PG8_BAR; PG8_WAIT_L(0); PG8_MMA(1, 0, At, B0); PG8_BAR; PG8_SCHED;
            PG8_STAGE(PG8_SB(0, 1), b2 + hstep, voffB);
            PG8_WAIT_V(6); PG8_BAR; PG8_MMA(1, 1, At, B1); PG8_BAR;
            PG8_LDB(B0, 1, 0); PG8_SCHED; PG8_LDA(At, 1, 0); PG8_STAGE(PG8_SA(0, 1), a2 + hstep, voffA);
            PG8_WAIT_L(8); PG8_BAR; PG8_WAIT_L(0); PG8_MMA(0, 0, At, B0); PG8_BAR; PG8_SCHED;
            PG8_LDB(B1, 1, 1); PG8_STAGE(PG8_SB(1, 0), b3, voffB);
            PG8_BAR; PG8_WAIT_L(0); PG8_MMA(0, 1, At, B1); PG8_BAR;
            PG8_LDA(At, 1, 1); PG8_STAGE(PG8_SA(1, 0), a3, voffA);
            PG8_BAR; PG8_WAIT_L(0); PG8_MMA(1, 0, At, B0); PG8_BAR; PG8_SCHED;
            PG8_STAGE(PG8_SB(1, 1), b3 + hstep, voffB);
            PG8_WAIT_V(6); PG8_BAR; PG8_MMA(1, 1, At, B1); PG8_BAR;
            }
        }
        if constexpr (ALIGN_EPI) { if (wr == 0) PG8_BAR; }
        if constexpr (!Epi::AFTER_DRAIN) { E(acc, cur, wr, wc, fr, fq); S.done(cur); }
        if (!has_next) break;
#pragma unroll
        for (int a = 0; a < 2; ++a)
#pragma unroll
            for (int b = 0; b < 2; ++b)
#pragma unroll
                for (int m = 0; m < 4; ++m)
#pragma unroll
                    for (int n = 0; n < 2; ++n) acc[a][b][m][n] = (f32x4){0.f, 0.f, 0.f, 0.f};
        cur = nxt; cA = nA; cB = nB; ++ui;
        if constexpr (ALIGN_EPI) { if (wr == 1) PG8_BAR; }
    }
    PG8_WAIT_V(0);
    if constexpr (!ALIGN_EPI) { if (wr == 0) PG8_BAR; }
    PG8_BAR;
    if constexpr (Epi::AFTER_DRAIN) { E.fused(acc, cur, wr, wc, fr, fq, lds, wid, lane); S.done(cur); }
#undef PG8_SA
#undef PG8_SB
#undef PG8_STAGE
#undef PG8_LDA
#undef PG8_LDB
#undef PG8_MMA
#undef PG8_WAIT_V
#undef PG8_WAIT_L
#undef PG8_BAR
#undef PG8_SCHED
}
}
namespace pg8 {
typedef float f32x2 __attribute__((ext_vector_type(2)));
__device__ __forceinline__ float silu_f(float v) { return v * __builtin_amdgcn_rcpf(1.0f + __builtin_amdgcn_exp2f(-1.4426950408889634f * v)); }

struct EpiSwiGLU {
    static constexpr bool PERM = true, AFTER_DRAIN = false;
    bf16_t* O; int ldc;
    __device__ __forceinline__ void operator()(const f32x4 (&acc)[2][2][4][2], const Unit& u, int wr, int wc, int fr, int fq) const {
        const int row0 = u.pm * BM + wr * 64 + fr, col0 = u.pn * HALF + wc * 32 + 8 * fq;
#pragma unroll
        for (int ai = 0; ai < 2; ++ai)
#pragma unroll
            for (int m = 0; m < 4; ++m) {
                bf16_t* rowp = O + (size_t)(row0 + ai * HALF + m * 16) * ldc + col0;
                const f32x4 a0 = acc[ai][0][m][0], a1 = acc[ai][0][m][1], g0 = acc[ai][1][m][0], g1 = acc[ai][1][m][1];
                u32x4 w;
                w.x = cvt_pk_bf16(silu_f(a0[0]) * g0[0], silu_f(a0[1]) * g0[1]); w.y = cvt_pk_bf16(silu_f(a0[2]) * g0[2], silu_f(a0[3]) * g0[3]);
                w.z = cvt_pk_bf16(silu_f(a1[0]) * g1[0], silu_f(a1[1]) * g1[1]); w.w = cvt_pk_bf16(silu_f(a1[2]) * g1[2], silu_f(a1[3]) * g1[3]);
                *(u32x4*)rowp = w;
            }
    }
};

struct EpiResid {
    static constexpr bool PERM = false, AFTER_DRAIN = false;
    const float* X; float* Y; const float* gate; int gate_ld; float coef, alpha;
    __device__ __forceinline__ void operator()(const f32x4 (&acc)[2][2][4][2], const Unit& u, int wr, int wc, int fr, int fq) const {
        const int col0 = u.pn * BM + wc * 32 + 4 * fq; const float* gb = gate + (size_t)(u.pm >> 3) * gate_ld + col0;
        f32x4 gv[2][2];
#pragma unroll
        for (int bj = 0; bj < 2; ++bj)
#pragma unroll
            for (int n = 0; n < 2; ++n) gv[bj][n] = *(const f32x4*)(gb + bj * HALF + n * 16) * coef;
#pragma unroll
        for (int ai = 0; ai < 2; ++ai)
#pragma unroll
            for (int m = 0; m < 4; ++m) { const size_t off = (size_t)(u.pm * BM + ai * HALF + wr * 64 + m * 16 + fr) * 1024 + col0;
#pragma unroll
                for (int bj = 0; bj < 2; ++bj)
#pragma unroll
                    for (int n = 0; n < 2; ++n) { const f32x4 xv = *(const f32x4*)(X + off + bj * HALF + n * 16);
                        *(f32x4*)(Y + off + bj * HALF + n * 16) = xv * alpha + gv[bj][n] * acc[ai][bj][m][n]; }
                if (m & 1) asm volatile("" ::: "memory"); }
    }
};

struct EpiInProj {
    static constexpr bool PERM = true, AFTER_DRAIN = false;
    bf16_t *Q, *QI, *K, *KI, *VT, *B4; float* SM; const float *cs, *sn;
    float qscale, wscale;
    __device__ __forceinline__ void rope_store(const f32x4 (&acc)[2][2][4][2], bf16_t* dst, int ld, int colbase, float sc, int row0, int fq) const {
        typedef unsigned u32x2 __attribute__((ext_vector_type(2)));
#pragma unroll
        for (int ai = 0; ai < 2; ++ai)
#pragma unroll
            for (int m = 0; m < 4; ++m) { const int r = row0 + ai * HALF + m * 16;
                bf16_t* p = dst + (size_t)r * ld + colbase + 8 * fq;
#pragma unroll
                for (int n = 0; n < 2; ++n) {
                    const f32x4 c0 = *(const f32x4*)(cs + (size_t)r * 32 + 8 * fq + 4 * n), s0 = *(const f32x4*)(sn + (size_t)r * 32 + 8 * fq + 4 * n);
                    const f32x4 x0 = acc[ai][0][m][n], y0 = acc[ai][1][m][n];
                    const f32x4 o0 = (x0 * c0 - y0 * s0) * sc, p0 = (y0 * c0 + x0 * s0) * sc;
                    u32x2 w; w.x = cvt_pk_bf16(o0[0], o0[1]); w.y = cvt_pk_bf16(o0[2], o0[3]); *(u32x2*)(p + 4 * n) = w;
                    w.x = cvt_pk_bf16(p0[0], p0[1]); w.y = cvt_pk_bf16(p0[2], p0[3]); *(u32x2*)(p + 32 + 4 * n) = w;
                    asm volatile("" ::: "memory"); } }
    }
    __device__ __forceinline__ void operator()(const f32x4 (&acc)[2][2][4][2], const Unit& u, int wr, int wc, int fr, int fq) const {
        const int row0 = u.pm * BM + wr * 64 + fr; const int pn = u.pn;
        if (pn < 2) { rope_store(acc, Q, 512, ((pn & 1) * 4 + wc) * 64, qscale, row0, fq); }
        else if (pn < 4) { rope_store(acc, QI, 512, ((pn & 1) * 4 + wc) * 64, 1.0f, row0, fq); }
        else if (pn == 4) {
            if (wc == 0) rope_store(acc, K, 64, 0, 1.0f, row0, fq);
            else if (wc == 1) rope_store(acc, KI, 64, 0, 1.0f, row0, fq);
            else if (wc == 2) {
#pragma unroll
                for (int ai = 0; ai < 2; ++ai)
#pragma unroll
                    for (int m = 0; m < 4; ++m) { const int r = row0 + ai * HALF + m * 16; const int b = r >> 11, t = r & 2047;
                        bf16_t* vb = VT + ((size_t)b * 64 + 8 * fq) * 2048 + t;
#pragma unroll
                        for (int bj = 0; bj < 2; ++bj) {
#pragma unroll
                            for (int n = 0; n < 2; ++n)
#pragma unroll
                                for (int i = 0; i < 4; i += 2) { const unsigned w = cvt_pk_bf16(acc[ai][bj][m][n][i], acc[ai][bj][m][n][i + 1]);
                                    vb[0] = (bf16_t)(w & 0xffffu); vb[2048] = (bf16_t)(w >> 16); vb += 2 * 2048; asm volatile("" : "+v"(vb)); }
                            vb += 24 * 2048; asm volatile("" : "+v"(vb) :: "memory"); } }
            } else {
                if (fq < 2) {
#pragma unroll
                    for (int ai = 0; ai < 2; ++ai)
#pragma unroll
                        for (int m = 0; m < 4; ++m) { const int r = row0 + ai * HALF + m * 16; const float s = (fq == 0) ? wscale : 1.0f;
                            *(f32x4*)(SM + (size_t)r * 16 + 8 * fq) = acc[ai][0][m][0] * s; *(f32x4*)(SM + (size_t)r * 16 + 8 * fq + 4) = acc[ai][0][m][1] * s; }
                }
            }
        } else {
            const int col0 = (pn - 5) * BM + wc * 32 + 8 * fq;
#pragma unroll
            for (int ai = 0; ai < 2; ++ai)
#pragma unroll
                for (int m = 0; m < 4; ++m) { bf16_t* rowp = B4 + (size_t)(row0 + ai * HALF + m * 16) * 2048 + col0;
#pragma unroll
                    for (int bj = 0; bj < 2; ++bj) { const f32x4 v0 = acc[ai][bj][m][0], v1 = acc[ai][bj][m][1]; u32x4 w;
                        w.x = cvt_pk_bf16(v0[0], v0[1]); w.y = cvt_pk_bf16(v0[2], v0[3]); w.z = cvt_pk_bf16(v1[0], v1[1]); w.w = cvt_pk_bf16(v1[2], v1[3]);
                        *(u32x4*)(rowp + bj * HALF) = w; } }
        }
    }
};
}
namespace cg = cooperative_groups;
#define LAS __attribute__((address_space(3)))
typedef unsigned short bf16;
typedef unsigned v4u __attribute__((ext_vector_type(4)));
typedef unsigned v2u __attribute__((ext_vector_type(2)));
typedef float f32x4 __attribute__((ext_vector_type(4)));
typedef float f32x16 __attribute__((ext_vector_type(16)));
typedef short bf16x8 __attribute__((ext_vector_type(8)));
typedef short bf16x4 __attribute__((ext_vector_type(4)));

constexpr int NWAVES = 8, NTHREADS = 512;
constexpr int BATCH = 16, SEQ = 2048, D = 1024, T = BATCH * SEQ, FF = 2816, NMOD = 9216;
constexpr int NIN = 3280, NINP = 3328;
constexpr float LN_EPS = 1e-5f, RMS_EPS = 1e-6f;
constexpr float ALPHA = 1.189207115002721f;
constexpr float LOG2E = 1.4426950408889634f;
constexpr float QSCALE = 0.125f * LOG2E;

constexpr size_t MiB = 1u << 20;
constexpr size_t WS_CTL = 0, CTL_ZERO_BYTES = 64 * 1024;
constexpr size_t WS_MOD = 1 * MiB, WS_COS = 2 * MiB, WS_SIN = 6 * MiB;
constexpr size_t WS_W13A = 10 * MiB, WS_W2A = 21 * MiB, WS_W13B = 27 * MiB, WS_W2B = 38 * MiB, WS_WIN = 44 * MiB, WS_WOUT = 51 * MiB;
constexpr size_t WS_SM = 53 * MiB, WS_K = 55 * MiB, WS_KI = 59 * MiB, WS_VT = 63 * MiB, WS_MASK = 67 * MiB, WS_QI = 75 * MiB, WS_AQK = 107 * MiB, WS_GL = 123 * MiB;
constexpr size_t WS_U = 124 * MiB;
constexpr size_t WS_X = 188 * MiB;
constexpr size_t WS_H = 316 * MiB;
constexpr size_t WS_B4 = WS_H, WS_Q = WS_H + 128 * MiB;
constexpr size_t WS_END = 492 * MiB;
constexpr int CW_QUEUE = 64;

__device__ __forceinline__ unsigned f2bf(float f) { unsigned u = __builtin_bit_cast(unsigned, f); return (u + 0x7fffu + ((u >> 16) & 1u)) >> 16; }
__device__ __forceinline__ unsigned pk2(float lo, float hi) { return f2bf(lo) | (f2bf(hi) << 16); }
__device__ __forceinline__ float bf2f(unsigned short h) { return __builtin_bit_cast(float, (unsigned)h << 16); }
__device__ __forceinline__ float wave_sum(float v) {
#pragma unroll
    for (int o = 1; o < 64; o <<= 1) v += __shfl_xor(v, o);
    return v;
}
#define LDS_WAIT() asm volatile("s_waitcnt lgkmcnt(0)" ::: "memory")

struct Args {
    const float *x, *c; const int* pos; const float *w_ada, *b_ada, *f1w1, *f1w3, *f1w2, *ln1g, *ln1b, *w_in, *conv_w, *a_log, *dt_bias, *dn_g, *w_out, *ln2g, *ln2b, *f2w1, *f2w3, *f2w2, *ln3g, *ln3b;
    float* out; unsigned char* ws;
};

__device__ __forceinline__ void p0_mod(const Args& A, LAS unsigned char* lds, int tid, int wave, int lane, int bid, int G) {
    LAS float* sc = (LAS float*)lds;
    LAS float* red = (LAS float*)(lds + 65536);
    float* mod = (float*)(A.ws + WS_MOD);
    bool have_sc = false;
    for (int task = bid; task < NMOD / 32; task += G) {
        if (!have_sc) { for (int i = tid; i < 16 * 1024; i += NTHREADS) { const float v = A.c[i]; sc[i] = v / (1.0f + __expf(-v)); } have_sc = true; __syncthreads(); }
        const int col = lane & 31, half = lane >> 5, j0 = task * 32;
        float acc[16];
#pragma unroll
        for (int b = 0; b < 16; ++b) acc[b] = 0.f;
#pragma unroll 4
        for (int i = 0; i < 64; ++i) { const int k = wave * 128 + 2 * i + half; const float wv = A.w_ada[(size_t)k * NMOD + j0 + col];
#pragma unroll
            for (int b = 0; b < 16; ++b) acc[b] += sc[b * 1024 + k] * wv; }
#pragma unroll
        for (int b = 0; b < 16; ++b) red[((wave * 2 + half) * 16 + b) * 32 + col] = acc[b];
        __syncthreads();
        { const int b = tid >> 5, cc = tid & 31; float s = A.b_ada[j0 + cc];
#pragma unroll
            for (int p = 0; p < 16; ++p) s += red[(p * 16 + b) * 32 + cc];
            mod[b * NMOD + j0 + cc] = s; }
        __syncthreads();
    }
}

template <class F>
__device__ __forceinline__ void transpose_item(const float* W, int K, int N, bf16* WT, F dstrow, LAS float* scr, int item, int lane) {
    const int nblk = (N + 31) / 32, kb = item / nblk, nb = item % nblk, k0 = 64 * kb, n0 = 32 * nb;
    const bool nok = (n0 + (lane & 31)) < N;
#pragma unroll 8
    for (int i = 0; i < 32; ++i) { const int kk = 2 * i + (lane >> 5); scr[kk * 33 + (lane & 31)] = nok ? W[(size_t)(k0 + kk) * N + n0 + (lane & 31)] : 0.f; }
    LDS_WAIT(); asm volatile("" ::: "memory");
    const int c = lane & 7;
#pragma unroll
    for (int j = 0; j < 4; ++j) { const int n = (lane >> 3) + 8 * j; const LAS float* s = scr + (8 * c) * 33 + n;
        v4u o; o.x = pk2(s[0 * 33], s[1 * 33]); o.y = pk2(s[2 * 33], s[3 * 33]); o.z = pk2(s[4 * 33], s[5 * 33]); o.w = pk2(s[6 * 33], s[7 * 33]);
        const int dr = (n0 + n < N) ? dstrow(n0 + n) : -1;
        if (dr >= 0) *(v4u*)(WT + (size_t)dr * K + k0 + 8 * c) = o; }
    LDS_WAIT(); asm volatile("" ::: "memory");
}
__device__ __forceinline__ int win_dst(int n) {
    if (n < 512) { const int head = n >> 6, d = n & 63; return 256 * (head >> 2) + 128 * (d >> 5) + 32 * (head & 3) + (d & 31); }
    if (n < 576) { const int d = n - 512; return 1024 + 128 * (d >> 5) + (d & 31); }
    if (n < 640) { const int d = n - 576; return 1024 + 128 * (d >> 5) + 64 + (d & 31); }
    if (n < 1152) { const int j = n - 640, head = j >> 6, d = j & 63; return 256 * (2 + (head >> 2)) + 128 * (d >> 5) + 32 * (head & 3) + (d & 31); }
    if (n < 1216) { const int d = n - 1152; return 1024 + 128 * (d >> 5) + 32 + (d & 31); }
    if (n < 1224) return 1024 + 96 + (n - 1216);
    if (n < 3272) return 1280 + (n - 1224);
    if (n < 3276) return 1024 + 96 + 8 + (n - 3272);
    return 1024 + 96 + 12 + (n - 3276);
}
__device__ __forceinline__ void p0_weights(const Args& A, LAS unsigned char* lds, int wave, int lane, int bid, int G) {
    LAS float* scr = (LAS float*)(lds + wave * 16384);
    const int gw = bid * NWAVES + wave, NGW = G * NWAVES;
    constexpr int I_13 = (D / 64) * (FF / 32), I_2 = (FF / 64) * (D / 32), I_IN = (D / 64) * ((NIN + 31) / 32), I_OUT = (D / 64) * (D / 32);
    constexpr int NITEMS = 4 * I_13 + 2 * I_2 + I_IN + I_OUT;
    bf16* W13A = (bf16*)(A.ws + WS_W13A); bf16* W2A = (bf16*)(A.ws + WS_W2A); bf16* W13B = (bf16*)(A.ws + WS_W13B); bf16* W2B = (bf16*)(A.ws + WS_W2B);
    bf16* WIN = (bf16*)(A.ws + WS_WIN); bf16* WOUT = (bf16*)(A.ws + WS_WOUT);
    auto d1 = [](int n) { return (n >> 7) * 256 + (n & 127); };
    auto d3 = [](int n) { return (n >> 7) * 256 + 128 + (n & 127); };
    auto id = [](int n) { return n; };
    for (int it = gw; it < NITEMS; it += NGW) {
        int r = it;
        if (r < I_13) { transpose_item(A.f1w1, D, FF, W13A, d1, scr, r, lane); continue; } r -= I_13;
        if (r < I_13) { transpose_item(A.f1w3, D, FF, W13A, d3, scr, r, lane); continue; } r -= I_13;
        if (r < I_13) { transpose_item(A.f2w1, D, FF, W13B, d1, scr, r, lane); continue; } r -= I_13;
        if (r < I_13) { transpose_item(A.f2w3, D, FF, W13B, d3, scr, r, lane); continue; } r -= I_13;
        if (r < I_2) { transpose_item(A.f1w2, FF, D, W2A, id, scr, r, lane); continue; } r -= I_2;
        if (r < I_2) { transpose_item(A.f2w2, FF, D, W2B, id, scr, r, lane); continue; } r -= I_2;
        if (r < I_IN) { transpose_item(A.w_in, D, NIN, WIN, [](int n) { return win_dst(n); }, scr, r, lane); continue; } r -= I_IN;
        transpose_item(A.w_out, D, D, WOUT, id, scr, r, lane);
    }
    for (int i = gw * 64 + lane; i < 48 * 128; i += NGW * 64) { const int rr = i >> 7, ch = i & 127; const int row = rr < 16 ? 1136 + rr : 1248 + (rr - 16);
        *(v4u*)(WIN + (size_t)row * D + ch * 8) = (v4u){0u, 0u, 0u, 0u}; }
}
__device__ __forceinline__ void p0_rope(const Args& A, int tid, int bid, int G) {
    float* cs = (float*)(A.ws + WS_COS); float* sn = (float*)(A.ws + WS_SIN);
    for (int i = bid * NTHREADS + tid; i < T * 32; i += G * NTHREADS) {
        const int t = i >> 5, j = i & 31;
        const float inv = (float)exp2(-(double)j * (13.287712379549449 / 32.0));
        const float ang = (float)A.pos[t] * inv;
        const double x = (double)ang; const double q = rint(x * 0.6366197723675814); const double y = x - q * 1.5707963267948966;
        const double y2 = y * y;
        const double sy = y * (1.0 + y2 * (-1.0 / 6 + y2 * (1.0 / 120 + y2 * (-1.0 / 5040 + y2 * (1.0 / 362880 + y2 * (-1.0 / 39916800 + y2 * (1.0 / 6227020800.0)))))));
        const double cy = 1.0 + y2 * (-0.5 + y2 * (1.0 / 24 + y2 * (-1.0 / 720 + y2 * (1.0 / 40320 + y2 * (-1.0 / 3628800 + y2 * (1.0 / 479001600 + y2 * (-1.0 / 87178291200.0)))))));
        const int qi = ((int)q) & 3;
        const double sv = (qi == 0) ? sy : (qi == 1) ? cy : (qi == 2) ? -sy : -cy;
        const double cv = (qi == 0) ? cy : (qi == 1) ? -sy : (qi == 2) ? -cy : sy;
        cs[i] = (float)cv; sn[i] = (float)sv;
    }
}
__device__ __forceinline__ void p_modulate_rows(const float* X, bf16* U, const float* mod, int sh_off, int sc_off, int wave, int lane, int bid, int G) {
    const int gw = bid * NWAVES + wave, NGW = G * NWAVES;
    for (int m = gw; m < T; m += NGW) { const int b = m >> 11; const float* mb = mod + (size_t)b * NMOD;
        const f32x4* xr = (const f32x4*)(X + (size_t)m * D) + lane; unsigned long long* o8 = (unsigned long long*)(U + (size_t)m * D) + lane;
#pragma unroll
        for (int j = 0; j < 4; ++j) { const f32x4 v = xr[64 * j]; const f32x4 sh = *((const f32x4*)(mb + sh_off) + lane + 64 * j), sc = *((const f32x4*)(mb + sc_off) + lane + 64 * j);
            const f32x4 u = v * (sc + 1.0f) + sh; o8[64 * j] = (unsigned long long)pk2(u.x, u.y) | ((unsigned long long)pk2(u.z, u.w) << 32); } }
}
__device__ __forceinline__ void p_ln_rows(const float* Y, float* XO, bf16* U, const float* g, const float* bb, const float* mod, int sh_off, int sc_off, int wave, int lane, int bid, int G) {
    const int gw = bid * NWAVES + wave, NGW = G * NWAVES;
    for (int m = gw; m < T; m += NGW) { const int b = m >> 11; const float* mb = mod + (size_t)b * NMOD;
        const f32x4* yr = (const f32x4*)(Y + (size_t)m * D) + lane;
        f32x4 v[4]; float s = 0.f;
#pragma unroll
        for (int j = 0; j < 4; ++j) { v[j] = yr[64 * j]; s += (v[j].x + v[j].y) + (v[j].z + v[j].w); }
        const float mean = wave_sum(s) * (1.f / D); float s2 = 0.f;
#pragma unroll
        for (int j = 0; j < 4; ++j) { v[j] = v[j] - mean; s2 += (v[j].x * v[j].x + v[j].y * v[j].y) + (v[j].z * v[j].z + v[j].w * v[j].w); }
        const float rstd = 1.f / sqrtf(wave_sum(s2) * (1.f / D) + LN_EPS);
#pragma unroll
        for (int j = 0; j < 4; ++j) { const f32x4 gg = *((const f32x4*)g + lane + 64 * j), be = *((const f32x4*)bb + lane + 64 * j);
            const f32x4 xo = v[j] * rstd * gg + be;
            if (XO) *((f32x4*)(XO + (size_t)m * D) + lane + 64 * j) = xo;
            if (U) { const f32x4 sh = *((const f32x4*)(mb + sh_off) + lane + 64 * j), sc = *((const f32x4*)(mb + sc_off) + lane + 64 * j);
                const f32x4 u = xo * (sc + 1.0f) + sh; *((unsigned long long*)(U + (size_t)m * D) + lane + 64 * j) = (unsigned long long)pk2(u.x, u.y) | ((unsigned long long)pk2(u.z, u.w) << 32); } } }
}
typedef unsigned short us16;
#define GAS __attribute__((address_space(1)))
template <int CTRL> __device__ __forceinline__ int dpp_i(int v) { return __builtin_amdgcn_update_dpp(0, v, CTRL, 0xf, 0xf, true); }
template <int CTRL> __device__ __forceinline__ float dpp_f(float v) { return __builtin_bit_cast(float, __builtin_amdgcn_update_dpp(0, __builtin_bit_cast(int, v), CTRL, 0xf, 0xf, true)); }
__device__ __forceinline__ int row16_sum_i(int x) { x += dpp_i<0xB1>(x); x += dpp_i<0x4E>(x); x += dpp_i<0x141>(x); x += dpp_i<0x140>(x); return x; }
__device__ __forceinline__ float row16_sum_f(float x) { x += dpp_f<0xB1>(x); x += dpp_f<0x4E>(x); x += dpp_f<0x141>(x); x += dpp_f<0x140>(x); return x; }
__device__ __forceinline__ unsigned half32_sum_u(unsigned x) { int y = row16_sum_i((int)x); y += __shfl_xor(y, 16); return (unsigned)y; }
__device__ __forceinline__ unsigned half32_max_u(unsigned x) {
#pragma unroll
    for (int o = 1; o < 32; o <<= 1) { const unsigned y = (unsigned)__shfl_xor((int)x, o); x = x > y ? x : y; }
    return x; }
__device__ __forceinline__ unsigned half32_min_u(unsigned x) {
#pragma unroll
    for (int o = 1; o < 32; o <<= 1) { const unsigned y = (unsigned)__shfl_xor((int)x, o); x = x < y ? x : y; }
    return x; }
__device__ __forceinline__ int crow(int r, int hi) { return (r & 3) + 8 * (r >> 2) + 4 * hi; }
__device__ __forceinline__ constexpr int sig(int p) { return 16 * ((p & 7) >> 2) + 4 * (p >> 3) + (p & 3); }
__device__ __forceinline__ constexpr int sig_inv(int x) { return 8 * ((x >> 2) & 3) + 4 * (x >> 4) + (x & 3); }
__device__ __forceinline__ unsigned pkbf(float lo, float hi) { return pg8::cvt_pk_bf16(lo, hi); }

__device__ __forceinline__ void indexer_unit(const Args& A, LAS unsigned char* lds, int b, int qb, int wave, int lane) {
    const unsigned char* ws = A.ws;
    const bf16* QI = (const bf16*)(ws + WS_QI); const bf16* KI = (const bf16*)(ws + WS_KI); const float* SM = (const float*)(ws + WS_SM);
    unsigned* MASK = (unsigned*)(ws + WS_MASK);
    const int r = lane & 31, hi = lane >> 5; const int t0 = qb * 32; const size_t tb = (size_t)b * SEQ;
    const int jn = qb + 1;
    bf16x8 af[4];
    { const int a = r >> 3, hq = (r >> 2) & 1, i = r & 3; const int qq = 2 * hq + (a >> 1), head = 4 * (a & 1) + i;
      const bf16* p = QI + (tb + t0 + 4 * wave + qq) * 512 + head * 64 + 8 * hi;
#pragma unroll
      for (int s = 0; s < 4; ++s) af[s] = *(const bf16x8*)(p + 16 * s); }
    float wq[2][8];
#pragma unroll
    for (int q2 = 0; q2 < 2; ++q2) { const float* p = SM + (tb + t0 + 4 * wave + 2 * hi + q2) * 16; const f32x4 w0 = *(const f32x4*)p, w1 = *(const f32x4*)(p + 4);
        wq[q2][0] = w0[0]; wq[q2][1] = w0[1]; wq[q2][2] = w0[2]; wq[q2][3] = w0[3]; wq[q2][4] = w1[0]; wq[q2][5] = w1[1]; wq[q2][6] = w1[2]; wq[q2][7] = w1[3]; }
    unsigned key[2][64];
    const int qloc0 = 4 * wave + 2 * hi;
    const GAS bf16* kp = (const GAS bf16*)(KI + (tb + r) * 64 + 8 * hi);
    bf16x8 cur[4], nxt[4];
#pragma unroll
    for (int s = 0; s < 4; ++s) { cur[s] = *(const GAS bf16x8*)(kp + 16 * s); nxt[s] = cur[s]; }
    int jn1 = jn; asm volatile("" : "+s"(jn1));
#pragma unroll
    for (int j = 0; j < 64; ++j) {
        if (j < jn1) {
            kp += 32 * 64; asm volatile("" : "+v"(kp));
            if (j + 1 < jn1) {
#pragma unroll
                for (int s = 0; s < 4; ++s) nxt[s] = *(const GAS bf16x8*)(kp + 16 * s);
            }
            f32x16 c = {};
#pragma unroll
            for (int s = 0; s < 4; ++s) c = __builtin_amdgcn_mfma_f32_32x32x16_bf16(af[s], cur[s], c, 0, 0, 0);
#pragma unroll
            for (int q2 = 0; q2 < 2; ++q2) { float s = 0.f;
#pragma unroll
                for (int hh = 0; hh < 8; ++hh) s += wq[q2][hh] * __builtin_fmaxf(c[8 * q2 + hh], 0.f);
                s += 0.0f;
                const unsigned u = __builtin_bit_cast(unsigned, s); unsigned k = (u >> 31) ? ~u : (u | 0x80000000u);
                if (j == jn1 - 1 && r > qloc0 + q2) k = 0u;
                key[q2][j] = k; }
#pragma unroll
            for (int s = 0; s < 4; ++s) cur[s] = nxt[s];
            __builtin_amdgcn_sched_barrier(0);
        } else { key[0][j] = 0u; key[1][j] = 0u; }
    }
    unsigned lo[2], hv[2], ksel[2];
#pragma unroll
    for (int q2 = 0; q2 < 2; ++q2) { unsigned mx = 0u, mn = 0xffffffffu;
#pragma unroll
        for (int j = 0; j < 64; ++j) { const unsigned k = key[q2][j]; mx = k > mx ? k : mx; const unsigned k1 = k - 1u; mn = k1 < mn ? k1 : mn; }
        hv[q2] = half32_max_u(mx); lo[q2] = half32_min_u(mn) + 1u; const int tq = t0 + qloc0 + q2; ksel[q2] = (unsigned)(tq + 1 < 256 ? tq + 1 : 256); if (tq + 1 <= 256) hv[q2] = lo[q2]; }
    int jn2 = jn; asm volatile("" : "+s"(jn2));
    while (__any((lo[0] < hv[0]) || (lo[1] < hv[1]))) {
        unsigned mid[2]; mid[0] = lo[0] + ((hv[0] - lo[0] + 1u) >> 1); mid[1] = lo[1] + ((hv[1] - lo[1] + 1u) >> 1);
        unsigned c0 = 0u, c1 = 0u;
#pragma unroll
        for (int jc = 0; jc < 8; ++jc) { if (8 * jc < jn2) {
#pragma unroll
            for (int j = 8 * jc; j < 8 * jc + 8; ++j) { c0 += (key[0][j] >= mid[0]) ? 1u : 0u; c1 += (key[1][j] >= mid[1]) ? 1u : 0u; } } }
        const unsigned tot = half32_sum_u(c0 | (c1 << 16));
        const unsigned t0c = tot & 0xffffu, t1c = tot >> 16;
        if (lo[0] < hv[0]) { if (t0c >= ksel[0]) lo[0] = mid[0]; else hv[0] = mid[0] - 1u; if (t0c == ksel[0]) hv[0] = mid[0]; }
        if (lo[1] < hv[1]) { if (t1c >= ksel[1]) lo[1] = mid[1]; else hv[1] = mid[1] - 1u; if (t1c == ksel[1]) hv[1] = mid[1]; }
    }
    unsigned need[2];
    { unsigned c0 = 0u, c1 = 0u;
#pragma unroll
      for (int j = 0; j < 64; ++j) { c0 += (key[0][j] > lo[0]) ? 1u : 0u; c1 += (key[1][j] > lo[1]) ? 1u : 0u; }
      const unsigned tot = half32_sum_u(c0 | (c1 << 16)); need[0] = ksel[0] - (tot & 0xffffu); need[1] = ksel[1] - (tot >> 16); }
    unsigned run[2] = {0u, 0u};
    const unsigned ltmask = (1u << r) - 1u;
    int jn3 = jn; asm volatile("" : "+s"(jn3));
    { unsigned lb = (unsigned)(uintptr_t)lds; asm volatile("" : "+v"(lb)); lds = (LAS unsigned char*)(uintptr_t)lb; }
    LAS unsigned* lm = (LAS unsigned*)lds + (wave * 4 + 2 * hi) * 64;
    lm[r] = 0u; lm[32 + r] = 0u; lm[64 + r] = 0u; lm[96 + r] = 0u;
#pragma unroll
    for (int j = 0; j < 64; ++j) {
        if (j < jn3) {
#pragma unroll
            for (int q2 = 0; q2 < 2; ++q2) { const unsigned k = key[q2][j]; const bool gt = k > lo[q2], eq = (k == lo[q2]);
                const unsigned long long be = __ballot(eq); const unsigned hm = hi ? (unsigned)(be >> 32) : (unsigned)be;
                const unsigned rank = run[q2] + (unsigned)__builtin_popcount(hm & ltmask); run[q2] += (unsigned)__builtin_popcount(hm);
                const bool sel = gt || (eq && rank < need[q2]);
                const unsigned long long bs = __ballot(sel); const unsigned sw = hi ? (unsigned)(bs >> 32) : (unsigned)bs;
                lm[q2 * 64 + j] = sw; }
            __builtin_amdgcn_sched_barrier(0);
        }
    }
#pragma unroll
    for (int q2 = 0; q2 < 2; ++q2) { unsigned* mp = MASK + (tb + t0 + qloc0 + q2) * 64; mp[r] = lm[q2 * 64 + r]; mp[32 + r] = lm[q2 * 64 + 32 + r]; }
    LDS_WAIT();
}
__device__ __forceinline__ void p6_indexer(const Args& A, LAS unsigned char* lds, int tid, int wave, int lane, int bid, int G) {
    for (int u = bid, it = 0; u < BATCH * 64; u += G, ++it) {
        int b, qb;
        if (G == 256) { b = bid >> 4; const int rr = bid & 15; qb = (it == 0) ? rr : (it == 1) ? 31 - rr : (it == 2) ? 32 + rr : 63 - rr; }
        else { b = u >> 6; qb = u & 63; }
        indexer_unit(A, lds, b, qb, wave, lane);
    }
}

constexpr int DN_L = 0, DN_KB = 65536, DN_QB = 82944, DN_SC = 100352;
__device__ __forceinline__ void dn_prep_unit(const Args& A, LAS unsigned char* lds, int b, int n, int h, int tid, int wave, int lane) {
    unsigned char* ws = A.ws;
    const bf16* B4 = (const bf16*)(ws + WS_B4); const float* SM = (const float*)(ws + WS_SM);
    bf16* NEGW = (bf16*)A.out; bf16* QD = NEGW + (size_t)T * 512; bf16* KDT = QD + (size_t)T * 512; bf16* UB = KDT + (size_t)T * 512;
    bf16* AQK = (bf16*)(ws + WS_AQK); float* GL = (float*)(ws + WS_GL);
    const int cu = (b * 32 + n) * 4 + h; const size_t tokb = (size_t)b * SEQ + 64 * n;
    { unsigned lb = (unsigned)(uintptr_t)lds; asm volatile("" : "+v"(lb)); lds = (LAS unsigned char*)(uintptr_t)lb; }
    LAS float* sq = (LAS float*)(lds + DN_L);
    LAS float* Lm = (LAS float*)(lds + DN_L);
    LAS us16* kb = (LAS us16*)(lds + DN_KB); LAS us16* qbuf = (LAS us16*)(lds + DN_QB);
    LAS float* s_la = (LAS float*)(lds + DN_SC);
    LAS float* s_beta = s_la + 64; LAS float* s_eg = s_la + 128; LAS float* s_ekd = s_la + 192; LAS float* s_rn = s_la + 256;
    float val[64];
    const int grp = tid >> 7, c = tid & 127;
    if (grp < 3) {
        const int col = grp * 512 + h * 128 + c;
        const float cw0 = A.conv_w[0 * 1536 + col], cw1 = A.conv_w[1 * 1536 + col], cw2 = A.conv_w[2 * 1536 + col], cw3 = A.conv_w[3 * 1536 + col];
        const bf16* src = B4 + tokb * 2048 + col;
        float x0 = 0.f, x1 = 0.f, x2 = 0.f;
        if (n > 0) { x0 = bf2f(src[-3 * 2048]); x1 = bf2f(src[-2 * 2048]); x2 = bf2f(src[-1 * 2048]); }
#pragma unroll
        for (int i = 0; i < 64; ++i) { const float x3 = bf2f(*src); src += 2048; asm volatile("" : "+v"(src)); const float y = cw0 * x0 + cw1 * x1 + cw2 * x2 + cw3 * x3; val[i] = pg8::silu_f(y); x0 = x1; x1 = x2; x2 = x3; }
        if (grp < 2) {
#pragma unroll
            for (int i = 0; i < 64; ++i) sq[(grp * 64 + i) * 128 + c] = val[i] * val[i];
        }
    } else {
#pragma unroll
        for (int i = 0; i < 64; ++i) val[i] = 0.f;
        if (c < 64) { const float* sm = SM + (tokb + c) * 16; const float ba = sm[8 + h], bb = sm[12 + h];
            const float z = ba + A.dt_bias[h]; const float sp = (z > 20.f) ? z : log1pf(__expf(z));
            s_la[c] = -__expf(A.a_log[h]) * sp; s_beta[c] = 1.0f / (1.0f + __expf(-bb)); }
    }
    __syncthreads();
    { const int row = tid >> 2, part = tid & 3; const LAS float* p = sq + row * 128 + 32 * part; float s = 0.f;
#pragma unroll
      for (int i = 0; i < 32; ++i) s += p[i];
      s += __shfl_xor(s, 1); s += __shfl_xor(s, 2);
      if (part == 0) s_rn[row] = 1.0f / sqrtf(s + RMS_EPS); }
    if (wave == 7) {
        float g = s_la[lane];
#pragma unroll
        for (int o = 1; o < 64; o <<= 1) { const float t = __shfl_up(g, o); if (lane >= o) g += t; }
        const float g63 = __shfl(g, 63);
        s_la[lane] = g; s_eg[lane] = __expf(g); s_ekd[lane] = __expf(g63 - g);
        if (lane == 0) GL[cu] = __expf(g63);
    }
    __syncthreads();
    if (grp == 0) {
#pragma unroll
        for (int i = 0; i < 64; ++i) { val[i] *= s_rn[i] * 0.08838834764831845f; qbuf[i * 136 + c] = (us16)f2bf(val[i]); }
        bf16* qd = QD + tokb * 512 + h * 128 + 32 * (c >> 5) + sig_inv(c & 31);
#pragma unroll
        for (int i = 0; i < 64; ++i) { *qd = (bf16)f2bf(val[i] * s_eg[i]); qd += 512; asm volatile("" : "+v"(qd)); }
    } else if (grp == 1) {
#pragma unroll
        for (int i = 0; i < 64; ++i) { val[i] *= s_rn[64 + i]; kb[i * 136 + c] = (us16)f2bf(val[i]); }
        bf16* kd = KDT + ((size_t)cu * 128 + c) * 64;
#pragma unroll
        for (int p8 = 0; p8 < 8; ++p8) { v4u o;
#define KDV(pp) (val[32 * ((8 * p8 + (pp)) >> 5) + sig((8 * p8 + (pp)) & 31)] * s_ekd[32 * ((8 * p8 + (pp)) >> 5) + sig((8 * p8 + (pp)) & 31)])
            o.x = pk2(KDV(0), KDV(1)); o.y = pk2(KDV(2), KDV(3)); o.z = pk2(KDV(4), KDV(5)); o.w = pk2(KDV(6), KDV(7));
#undef KDV
            *(v4u*)(kd + 8 * p8) = o; }
    }
    __syncthreads();
    if (wave < 6) {
        const int tI = (wave % 3) >= 1 ? 1 : 0, tJ = (wave % 3) == 2 ? 1 : 0; const bool isq = wave >= 3;
        const int r = lane & 31, hi = lane >> 5;
        const LAS us16* ap = (isq ? qbuf : kb) + (32 * tI + r) * 136 + 8 * hi; const LAS us16* bp = kb + (32 * tJ + r) * 136 + 8 * hi;
        f32x16 cacc = {};
#pragma unroll
        for (int s = 0; s < 8; ++s) { const bf16x8 a = *(const LAS bf16x8*)(ap + 16 * s), bb = *(const LAS bf16x8*)(bp + 16 * s); cacc = __builtin_amdgcn_mfma_f32_32x32x16_bf16(a, bb, cacc, 0, 0, 0); }
        const int j = 32 * tJ + r; const float gj = s_la[j];
#pragma unroll
        for (int reg = 0; reg < 16; ++reg) { const int i = 32 * tI + crow(reg, hi); const float gi = s_la[i];
            if (!isq) { const bool m = j < i; const float v = m ? s_beta[i] * cacc[reg] * __expf(m ? gi - gj : 0.f) : 0.f; Lm[i * 68 + j] = v; }
            else { const bool m = j <= i; const float v = m ? cacc[reg] * __expf(m ? gi - gj : 0.f) : 0.f; AQK[(size_t)cu * 4096 + i * 64 + 32 * tJ + sig_inv(r)] = (bf16)f2bf(v); } }
    } else if (wave == 6) {
        for (int e = lane; e < 32 * 32 / 8; e += 64) { const int i = e >> 2, ch = e & 3; *(v4u*)(AQK + (size_t)cu * 4096 + i * 64 + 32 + 8 * ch) = (v4u){0u, 0u, 0u, 0u}; }
    }
    __syncthreads();
    if (grp == 1 || grp == 2) {
#pragma unroll
        for (int i = 0; i < 64; ++i) val[i] *= (grp == 1) ? s_beta[i] * s_eg[i] : s_beta[i];
#pragma unroll
        for (int i = 1; i < 64; ++i) { float a0 = 0.f, a1 = 0.f, a2 = 0.f, a3 = 0.f;
#pragma unroll
            for (int m4 = 0; m4 < (i + 3) / 4; ++m4) { const f32x4 l4 = *(const LAS f32x4*)(Lm + i * 68 + 4 * m4);
                a0 += l4[0] * val[4 * m4];
                if (4 * m4 + 1 < i) a1 += l4[1] * val[4 * m4 + 1];
                if (4 * m4 + 2 < i) a2 += l4[2] * val[4 * m4 + 2];
                if (4 * m4 + 3 < i) a3 += l4[3] * val[4 * m4 + 3]; }
            val[i] -= (a0 + a1) + (a2 + a3); }
        if (grp == 1) { bf16* wp = NEGW + tokb * 512 + h * 128 + 32 * (c >> 5) + sig_inv(c & 31);
#pragma unroll
            for (int i = 0; i < 64; ++i) { *wp = (bf16)f2bf(-val[i]); wp += 512; asm volatile("" : "+v"(wp)); }
        } else { bf16* up = UB + tokb * 512 + h * 128 + c;
#pragma unroll
            for (int i = 0; i < 64; ++i) { *up = (bf16)f2bf(val[i]); up += 512; asm volatile("" : "+v"(up)); } }
    }
    __syncthreads();
}
__device__ __forceinline__ void p6_dn_prep(const Args& A, LAS unsigned char* lds, int tid, int wave, int lane, int bid, int G) {
    for (int u = bid; u < BATCH * 32 * 4; u += G) { const int h = u & 3, n = (u >> 2) & 31, b = u >> 7; dn_prep_unit(A, lds, b, n, h, tid, wave, lane); }
}

__device__ __forceinline__ void attn_unit(const Args& A, LAS unsigned char* lds, int b, int qb, int wave, int lane) {
    const unsigned char* ws = A.ws;
    const bf16* Q = (const bf16*)(ws + WS_Q); const bf16* K = (const bf16*)(ws + WS_K); const bf16* VT = (const bf16*)(ws + WS_VT); const unsigned* MASK = (const unsigned*)(ws + WS_MASK);
    bf16* MIX = (bf16*)(A.ws + WS_U);
    LAS float* wsf = (LAS float*)(lds + 4096) + wave * 32;
    const int r = lane & 31, hi = lane >> 5, t0 = qb * 32; const size_t tb = (size_t)b * SEQ; const int hd = wave;
    bf16x8 qf[4];
    { const bf16* p = Q + (tb + t0 + r) * 512 + hd * 64 + 8 * hi;
#pragma unroll
      for (int s = 0; s < 4; ++s) qf[s] = *(const bf16x8*)(p + 16 * s); }
    const unsigned* mrow = MASK + (tb + t0 + r) * 64;
    const bf16* vt0 = VT + ((size_t)b * 64 + r) * 2048 + 4 * hi;
    f32x16 o0 = {}, o1 = {}; float mrun = -1e30f, lsum = 0.f;
    for (int j = 0; j <= qb; ++j) {
        const bf16* kp = K + (tb + 32 * j + r) * 64 + 8 * hi;
        f32x16 sc = {};
#pragma unroll
        for (int s = 0; s < 4; ++s) { const bf16x8 kf = *(const bf16x8*)(kp + 16 * s); sc = __builtin_amdgcn_mfma_f32_32x32x16_bf16(kf, qf[s], sc, 0, 0, 0); }
        const unsigned mw = mrow[j];
        float mx = -INFINITY;
#pragma unroll
        for (int reg = 0; reg < 16; ++reg) { const int kk = crow(reg, 0) + 4 * hi; sc[reg] = ((mw >> kk) & 1u) ? sc[reg] : -INFINITY; mx = __builtin_fmaxf(mx, sc[reg]); }
        mx = __builtin_fmaxf(mx, __shfl_xor(mx, 32));
        const float mnew = __builtin_fmaxf(mrun, mx); const float alpha = __builtin_amdgcn_exp2f(mrun - mnew); mrun = mnew;
        float ps = 0.f;
#pragma unroll
        for (int reg = 0; reg < 16; ++reg) { sc[reg] = __builtin_amdgcn_exp2f(sc[reg] - mnew); ps += sc[reg]; }
        lsum = lsum * alpha + ps;
        if (__any(alpha != 1.0f)) {
            if (hi == 0) wsf[r] = alpha;
            LDS_WAIT();
#pragma unroll
            for (int reg = 0; reg < 16; ++reg) { const float f = wsf[crow(reg, hi)]; o0[reg] *= f; o1[reg] *= f; }
            LDS_WAIT();
        }
        bf16x8 pa[2];
#pragma unroll
        for (int s2 = 0; s2 < 2; ++s2) { v4u w; w.x = pkbf(sc[8 * s2 + 0], sc[8 * s2 + 1]); w.y = pkbf(sc[8 * s2 + 2], sc[8 * s2 + 3]); w.z = pkbf(sc[8 * s2 + 4], sc[8 * s2 + 5]); w.w = pkbf(sc[8 * s2 + 6], sc[8 * s2 + 7]); pa[s2] = __builtin_bit_cast(bf16x8, w); }
#pragma unroll
        for (int s2 = 0; s2 < 2; ++s2) {
            const bf16* vp = vt0 + 32 * j + 16 * s2;
            const v2u a0 = *(const v2u*)vp, a1 = *(const v2u*)(vp + 8), b0 = *(const v2u*)(vp + 32 * 2048), b1 = *(const v2u*)(vp + 32 * 2048 + 8);
            const bf16x8 v0 = __builtin_bit_cast(bf16x8, (v4u){a0.x, a0.y, a1.x, a1.y}), v1 = __builtin_bit_cast(bf16x8, (v4u){b0.x, b0.y, b1.x, b1.y});
            o0 = __builtin_amdgcn_mfma_f32_32x32x16_bf16(pa[s2], v0, o0, 0, 0, 0);
            o1 = __builtin_amdgcn_mfma_f32_32x32x16_bf16(pa[s2], v1, o1, 0, 0, 0);
        }
    }
    lsum += __shfl_xor(lsum, 32);
    if (hi == 0) wsf[r] = 1.0f / lsum;
    LDS_WAIT();
    bf16* op = MIX + (tb + t0) * 1024 + hd * 64 + r;
#pragma unroll
    for (int reg = 0; reg < 16; ++reg) { const int q = crow(reg, hi); const float f = wsf[q]; op[(size_t)q * 1024] = (bf16)f2bf(o0[reg] * f); op[(size_t)q * 1024 + 32] = (bf16)f2bf(o1[reg] * f); }
    LDS_WAIT();
}

__device__ __forceinline__ void dn_scan_unit(const Args& A, LAS unsigned char* lds, int b, int h, int tid, int wave, int lane) {
    unsigned char* ws = A.ws;
    const bf16* NEGW = (const bf16*)A.out; const bf16* QD = NEGW + (size_t)T * 512; const bf16* KDT = QD + (size_t)T * 512; const bf16* UB = KDT + (size_t)T * 512;
    const bf16* AQK = (const bf16*)(ws + WS_AQK); const float* GL = (const float*)(ws + WS_GL); const bf16* B4 = (const bf16*)(ws + WS_B4);
    bf16* MIX = (bf16*)(ws + WS_U);
    LAS float* ssq = (LAS float*)(lds + 8192);
    const int fr = lane & 15, g = lane >> 4; const int dv = 16 * wave + fr;
    const float gn = A.dn_g[dv];
    f32x4 S[8];
#pragma unroll
    for (int a = 0; a < 8; ++a) S[a] = (f32x4){0.f, 0.f, 0.f, 0.f};
    for (int n = 0; n < 32; ++n) {
        const int cu = (b * 32 + n) * 4 + h; const size_t tokb = (size_t)b * SEQ + 64 * n;
        const float gl = GL[cu];
        bf16x8 Bs[4];
#pragma unroll
        for (int s = 0; s < 4; ++s) { v4u w; w.x = pkbf(S[2 * s][0], S[2 * s][1]); w.y = pkbf(S[2 * s][2], S[2 * s][3]); w.z = pkbf(S[2 * s + 1][0], S[2 * s + 1][1]); w.w = pkbf(S[2 * s + 1][2], S[2 * s + 1][3]); Bs[s] = __builtin_bit_cast(bf16x8, w); }
        f32x4 dl[4], ot[4];
#pragma unroll
        for (int m = 0; m < 4; ++m) {
            const bf16* up = UB + (tokb + 16 * m + 4 * g) * 512 + h * 128 + dv;
            f32x4 d = (f32x4){bf2f(up[0]), bf2f(up[512]), bf2f(up[1024]), bf2f(up[1536])};
            f32x4 o = (f32x4){0.f, 0.f, 0.f, 0.f};
            const bf16* wp = NEGW + (tokb + 16 * m + fr) * 512 + h * 128 + 8 * g; const bf16* qp = QD + (tokb + 16 * m + fr) * 512 + h * 128 + 8 * g;
#pragma unroll
            for (int s = 0; s < 4; ++s) { const bf16x8 wa = *(const bf16x8*)(wp + 32 * s), qa = *(const bf16x8*)(qp + 32 * s);
                d = __builtin_amdgcn_mfma_f32_16x16x32_bf16(wa, Bs[s], d, 0, 0, 0); o = __builtin_amdgcn_mfma_f32_16x16x32_bf16(qa, Bs[s], o, 0, 0, 0); }
            dl[m] = d; ot[m] = o;
        }
        bf16x8 Bd[2];
#pragma unroll
        for (int s2 = 0; s2 < 2; ++s2) { v4u w; w.x = pkbf(dl[2 * s2][0], dl[2 * s2][1]); w.y = pkbf(dl[2 * s2][2], dl[2 * s2][3]); w.z = pkbf(dl[2 * s2 + 1][0], dl[2 * s2 + 1][1]); w.w = pkbf(dl[2 * s2 + 1][2], dl[2 * s2 + 1][3]); Bd[s2] = __builtin_bit_cast(bf16x8, w); }
#pragma unroll
        for (int m = 0; m < 4; ++m) { const bf16* ap = AQK + (size_t)cu * 4096 + (16 * m + fr) * 64 + 8 * g;
#pragma unroll
            for (int s2 = 0; s2 < 2; ++s2) { const bf16x8 aa = *(const bf16x8*)(ap + 32 * s2); ot[m] = __builtin_amdgcn_mfma_f32_16x16x32_bf16(aa, Bd[s2], ot[m], 0, 0, 0); } }
#pragma unroll
        for (int a = 0; a < 8; ++a) { const bf16* kp = KDT + ((size_t)cu * 128 + 16 * a + fr) * 64 + 8 * g; f32x4 sn = S[a] * gl;
#pragma unroll
            for (int s2 = 0; s2 < 2; ++s2) { const bf16x8 ka = *(const bf16x8*)(kp + 32 * s2); sn = __builtin_amdgcn_mfma_f32_16x16x32_bf16(ka, Bd[s2], sn, 0, 0, 0); }
            S[a] = sn; }
        LAS float* sb = ssq + (n & 1) * 512;
#pragma unroll
        for (int m = 0; m < 4; ++m)
#pragma unroll
            for (int rho = 0; rho < 4; ++rho) { const float q = row16_sum_f(ot[m][rho] * ot[m][rho]); if (fr == 0) sb[wave * 64 + 16 * m + 4 * g + rho] = q; }
        __syncthreads();
#pragma unroll
        for (int m = 0; m < 4; ++m)
#pragma unroll
            for (int rho = 0; rho < 4; ++rho) { const int tk = 16 * m + 4 * g + rho; float q = 0.f;
#pragma unroll
                for (int w8 = 0; w8 < 8; ++w8) q += sb[w8 * 64 + tk];
                const float rinv = 1.0f / sqrtf(q * (1.0f / 128.0f) + RMS_EPS);
                const float z = bf2f(B4[(tokb + tk) * 2048 + 1536 + h * 128 + dv]);
                MIX[(tokb + tk) * 1024 + 512 + h * 128 + dv] = (bf16)f2bf(ot[m][rho] * rinv * gn * pg8::silu_f(z)); }
    }
    __syncthreads();
}
__device__ __forceinline__ void p7_mixer(const Args& A, LAS unsigned char* lds, int tid, int wave, int lane, int bid, int G) {
    if (bid < BATCH * 4) dn_scan_unit(A, lds, bid >> 2, bid & 3, tid, wave, lane);
    else if (G < BATCH * 4 + 1 && bid == 0) { for (int u = G; u < BATCH * 4; ++u) dn_scan_unit(A, lds, u >> 2, u & 3, tid, wave, lane); }
    unsigned* ctr = (unsigned*)(A.ws + WS_CTL) + CW_QUEUE;
    LAS unsigned* slot = (LAS unsigned*)(lds + 2048);
    for (;;) {
        if (tid == 0) slot[0] = atomicAdd(ctr, 1u);
        __syncthreads();
        const unsigned u = slot[0];
        __syncthreads();
        if (u >= (unsigned)(BATCH * 64)) break;
        const int qb = 63 - (int)(u >> 4), b = (int)(u & 15);
        attn_unit(A, lds, b, qb, wave, lane);
    }
}
constexpr int LDS_BYTES = 147456;
#ifndef MIXER
#define MIXER 1
#endif

__global__ void __launch_bounds__(NTHREADS, 2) fwd_megakernel(Args A) {
    extern __shared__ __attribute__((aligned(16))) unsigned char lds_raw[];
    cg::grid_group grid = cg::this_grid();
    LAS unsigned char* lds = (LAS unsigned char*)lds_raw;
    const int tid = threadIdx.x, lane = tid & 63, wave = __builtin_amdgcn_readfirstlane(tid >> 6);
    const int bid = blockIdx.x, G = gridDim.x;
    unsigned char* ws = A.ws;
    float* mod = (float*)(ws + WS_MOD);
    bf16* U = (bf16*)(ws + WS_U); bf16* H = (bf16*)(ws + WS_H); float* X = (float*)(ws + WS_X); float* Y = A.out;
    bf16* MIX = U;

    p0_mod(A, lds, tid, wave, lane, bid, G);
    p0_weights(A, lds, wave, lane, bid, G);
    p0_rope(A, tid, bid, G);
    grid.sync();
    p_modulate_rows(A.x, U, mod, 0 * D, 1 * D, wave, lane, bid, G);
    grid.sync();
    { pg8::Gemm g{U, (const bf16*)(ws + WS_W13A), T, 2 * FF, D}; pg8::StaticOrder S; S.init(T, 2 * FF, G, bid);
      pg8::EpiSwiGLU E{H, FF}; pg8::gemm_phase<pg8::EpiSwiGLU, pg8::StaticOrder, true, true>(lds, g, S, E); }
    grid.sync();
    { pg8::Gemm g{H, (const bf16*)(ws + WS_W2A), T, D, FF}; pg8::StaticOrder S; S.init(T, D, G, bid);
      pg8::EpiResid E{A.x, Y, mod + 2 * D, NMOD, 0.5f, ALPHA}; pg8::gemm_phase<pg8::EpiResid, pg8::StaticOrder, true, true>(lds, g, S, E); }
    grid.sync();
    p_ln_rows(Y, X, U, A.ln1g, A.ln1b, mod, 3 * D, 4 * D, wave, lane, bid, G);
    grid.sync();
#if MIXER
    { pg8::Gemm g{U, (const bf16*)(ws + WS_WIN), T, NINP, D}; pg8::StaticOrder S; S.init(T, NINP, G, bid);
      pg8::EpiInProj E{(bf16*)(ws + WS_Q), (bf16*)(ws + WS_QI), (bf16*)(ws + WS_K), (bf16*)(ws + WS_KI), (bf16*)(ws + WS_VT), (bf16*)(ws + WS_B4), (float*)(ws + WS_SM),
                       (const float*)(ws + WS_COS), (const float*)(ws + WS_SIN), QSCALE, 0.04419417382415922f};
      pg8::gemm_phase<pg8::EpiInProj, pg8::StaticOrder, true, true>(lds, g, S, E); }
    grid.sync();
    p6_indexer(A, lds, tid, wave, lane, bid, G);
    __syncthreads();
    p6_dn_prep(A, lds, tid, wave, lane, bid, G);
    grid.sync();
    p7_mixer(A, lds, tid, wave, lane, bid, G);
    grid.sync();
#else
    for (size_t i = (size_t)bid * NTHREADS + tid; i < (size_t)T * D / 8; i += (size_t)G * NTHREADS) ((v4u*)MIX)[i] = (v4u){0u, 0u, 0u, 0u};
    grid.sync();
#endif
    { pg8::Gemm g{MIX, (const bf16*)(ws + WS_WOUT), T, D, D}; pg8::StaticOrder S; S.init(T, D, G, bid);
      pg8::EpiResid E{X, Y, mod + 5 * D, NMOD, 1.0f, ALPHA}; pg8::gemm_phase<pg8::EpiResid, pg8::StaticOrder, true, true>(lds, g, S, E); }
    grid.sync();
    p_ln_rows(Y, X, U, A.ln2g, A.ln2b, mod, 6 * D, 7 * D, wave, lane, bid, G);
    grid.sync();
    { pg8::Gemm g{U, (const bf16*)(ws + WS_W13B), T, 2 * FF, D}; pg8::StaticOrder S; S.init(T, 2 * FF, G, bid);
      pg8::EpiSwiGLU E{H, FF}; pg8::gemm_phase<pg8::EpiSwiGLU, pg8::StaticOrder, true, true>(lds, g, S, E); }
    grid.sync();
    { pg8::Gemm g{H, (const bf16*)(ws + WS_W2B), T, D, FF}; pg8::StaticOrder S; S.init(T, D, G, bid);
      pg8::EpiResid E{X, Y, mod + 8 * D, NMOD, 0.5f, ALPHA}; pg8::gemm_phase<pg8::EpiResid, pg8::StaticOrder, true, true>(lds, g, S, E); }
    grid.sync();
    p_ln_rows(Y, Y, nullptr, A.ln3g, A.ln3b, mod, 0, 0, wave, lane, bid, G);
}

extern "C" void kernel_launch(void* const* d_in, const int* in_sizes, int n_in, void* d_out, int out_size, void* d_ws, size_t ws_size, hipStream_t stream) {
    static int grid_blocks = 0;
    if (grid_blocks == 0) {
        if (n_in != 23 || out_size != T * D || ws_size < WS_END) { fprintf(stderr, "kernel_launch: unexpected shapes (n_in %d out %d ws %zu)\n", n_in, out_size, ws_size); grid_blocks = -1; return; }
        int dev = 0, cus = 0, per_cu = 0;
        (void)hipGetDevice(&dev); (void)hipDeviceGetAttribute(&cus, hipDeviceAttributeMultiprocessorCount, dev);
        if (hipFuncSetAttribute((const void*)fwd_megakernel, hipFuncAttributeMaxDynamicSharedMemorySize, LDS_BYTES) != hipSuccess) { fprintf(stderr, "kernel_launch: hipFuncSetAttribute failed\n"); grid_blocks = -1; return; }
        if (hipOccupancyMaxActiveBlocksPerMultiprocessor(&per_cu, (const void*)fwd_megakernel, NTHREADS, LDS_BYTES) != hipSuccess || per_cu < 1) { fprintf(stderr, "kernel_launch: occupancy query says %d\n", per_cu); per_cu = 1; }
        (void)hipGetLastError();
        grid_blocks = cus * 1;
        fprintf(stderr, "kernel_launch: cus %d per_cu %d grid %d\n", cus, per_cu, grid_blocks);
    }
    if (grid_blocks < 0) return;
    (void)hipMemsetAsync((char*)d_ws + WS_CTL, 0, CTL_ZERO_BYTES, stream);
    Args a{};
    const float** fp = (const float**)&a;
    a.x = (const float*)d_in[0]; a.c = (const float*)d_in[1]; a.pos = (const int*)d_in[2]; a.w_ada = (const float*)d_in[3]; a.b_ada = (const float*)d_in[4];
    a.f1w1 = (const float*)d_in[5]; a.f1w3 = (const float*)d_in[6]; a.f1w2 = (const float*)d_in[7]; a.ln1g = (const float*)d_in[8]; a.ln1b = (const float*)d_in[9];
    a.w_in = (const float*)d_in[10]; a.conv_w = (const float*)d_in[11]; a.a_log = (const float*)d_in[12]; a.dt_bias = (const float*)d_in[13]; a.dn_g = (const float*)d_in[14];
    a.w_out = (const float*)d_in[15]; a.ln2g = (const float*)d_in[16]; a.ln2b = (const float*)d_in[17]; a.f2w1 = (const float*)d_in[18]; a.f2w3 = (const float*)d_in[19];
    a.f2w2 = (const float*)d_in[20]; a.ln3g = (const float*)d_in[21]; a.ln3b = (const float*)d_in[22];
    (void)fp;
    a.out = (float*)d_out; a.ws = (unsigned char*)d_ws;
    void* args[] = {&a};
    hipError_t e = hipLaunchCooperativeKernel((const void*)fwd_megakernel, dim3(grid_blocks), dim3(NTHREADS), args, LDS_BYTES, stream);
    if (e != hipSuccess) fprintf(stderr, "kernel_launch: cooperative launch failed: %s (grid %d)\n", hipGetErrorString(e), grid_blocks);
}
```

```cpp
#define MIXER 1
#define BARSEL 0
#define DUP 0
#include <hip/hip_runtime.h>
#include <hip/hip_cooperative_groups.h>
#include <cstdio>
#include <cstdint>
namespace pg8 {
#define PG8_LAS __attribute__((address_space(3)))
typedef unsigned short bf16_t;
typedef short bf16x8 __attribute__((ext_vector_type(8)));
typedef float f32x4 __attribute__((ext_vector_type(4)));
typedef unsigned u32x4 __attribute__((ext_vector_type(4)));
constexpr int BM = 256, BK = 64, HALF = 128, HTB = HALF * BK * 2  , STAGE_BYTES = 8 * HTB, NXCD = 8, WGM = 8;

__host__ __device__ __forceinline__ int lds_byte(int r, int c) { const int st = (r >> 4) * 2 + (c >> 5), rr = r & 15, cc = c & 31, ob = rr * 64 + cc * 2; return st * 1024 + (ob ^ (((ob >> 9) & 1) << 5)); }
__host__ __device__ __forceinline__ void stage_rc(int b, int& R, int& C) { const int st = b / 1024, sb = b % 1024, swz = sb ^ (((sb >> 9) & 1) << 5); R = (st >> 1) * 16 + swz / 64; C = (st & 1) * 32 + (swz % 64) / 2; }
__host__ __device__ __forceinline__ int perm32(int rho) { const int n = rho >> 4, i = rho & 15; return 8 * (i >> 2) + 4 * n + (i & 3); }

struct Unit { int pm, pn; };
struct Gemm { const bf16_t* A; const bf16_t* Bt; int M, N, K; };

struct StaticOrder {
    int nM, nN, nwg, G, c;
    __host__ __device__ void init(int M, int N, int G_, int c_) { nM = M / BM; nN = N / BM; nwg = nM * nN; G = G_; c = c_; }
    __host__ __device__ bool next(int i, Unit& u) const {
        const long L = (long)i * G + c; if (L >= nwg) return false;
        int wgid = (int)L; { const int q = nwg / NXCD, r = nwg % NXCD, xcd = wgid % NXCD, off = wgid / NXCD; wgid = (xcd < r ? xcd * (q + 1) : r * (q + 1) + (xcd - r) * q) + off; }
        const int nig = WGM * nN, gid = wgid / nig, fm = gid * WGM, gsz = (nM - fm) < WGM ? (nM - fm) : WGM;
        u.pm = fm + ((wgid % nig) % gsz); u.pn = (wgid % nig) / gsz; return true;
    }
    __device__ __forceinline__ void a_ready(const Unit&) const {}
    __device__ __forceinline__ void done(const Unit&) const {}
};

typedef float f32x2_t __attribute__((ext_vector_type(2))); typedef __bf16 bf16x2_t __attribute__((ext_vector_type(2)));
__device__ __forceinline__ unsigned cvt_pk_bf16(float lo, float hi) { f32x2_t v = {lo, hi}; bf16x2_t b = __builtin_convertvector(v, bf16x2_t); return __builtin_bit_cast(unsigned, b); }
template <class Epi, class Sched, bool ALIGN_EPI = false, bool SP2 = false>
__device__ __forceinline__ void gemm_phase(PG8_LAS unsigned char* lds, const Gemm g, const Sched& S, const Epi& E) {
    int tid_ = threadIdx.x; asm volatile("" : "+v"(tid_));
    const int tid = tid_, wid = __builtin_amdgcn_readfirstlane(tid >> 6), lane = tid & 63, wr = wid >> 2, wc = wid & 3, fr = lane & 15, fq = lane >> 4;
    const int K = g.K, nt = K / BK;
    unsigned voffA[2], voffB[2];
#pragma unroll
    for (int i = 0; i < 2; ++i) { int R, C; stage_rc(tid * 16 + i * 8192, R, C); const int Rb = Epi::PERM ? ((R & ~31) + perm32(R & 31)) : R;
        voffA[i] = (unsigned)(R * K + C) * 2u; voffB[i] = (unsigned)(Rb * K + C) * 2u; }
    const size_t kstep = (size_t)(BK * 2);
    const size_t hstep = (size_t)HALF * K * 2;
    const size_t tstep = 2 * hstep;
    const unsigned ldsw = (unsigned)wid * 1024u;
    const int aoff = lds_byte(wr * 64 + fr, fq * 8), boff = lds_byte(wc * 32 + fr, fq * 8);
#define PG8_SA(b, h) (((b) * 2 + (h)) * HTB)
#define PG8_SB(b, h) ((4 + (b) * 2 + (h)) * HTB)
#define PG8_STAGE(bufoff, gbase, voff) do { _Pragma("unroll") for (int _i = 0; _i < 2; ++_i) \
        __builtin_amdgcn_global_load_lds((const unsigned*)((const char*)(gbase) + (voff)[_i]), (PG8_LAS unsigned*)(lds + (bufoff) + ldsw + _i * 8192), 16, 0, 0); } while (0)
#define PG8_LDA(dst, b, h) do { _Pragma("unroll") for (int m = 0; m < 4; ++m) _Pragma("unroll") for (int k = 0; k < 2; ++k) dst[m][k] = *(const PG8_LAS bf16x8*)(lds + PG8_SA(b, h) + aoff + m * 2048 + k * 1024); } while (0)
#define PG8_LDB(dst, b, h) do { _Pragma("unroll") for (int n = 0; n < 2; ++n) _Pragma("unroll") for (int k = 0; k < 2; ++k) dst[n][k] = *(const PG8_LAS bf16x8*)(lds + PG8_SB(b, h) + boff + n * 2048 + k * 1024); } while (0)
#define PG8_MMA(ai, bj, At, Bt) do { __builtin_amdgcn_s_setprio(1); _Pragma("unroll") for (int m = 0; m < 4; ++m) _Pragma("unroll") for (int n = 0; n < 2; ++n) _Pragma("unroll") for (int k = 0; k < 2; ++k) \
        acc[ai][bj][m][n] = __builtin_amdgcn_mfma_f32_16x16x32_bf16(Bt[n][k], At[m][k], acc[ai][bj][m][n], 0, 0, 0); __builtin_amdgcn_s_setprio(0); } while (0)
#define PG8_WAIT_V(n) asm volatile("s_waitcnt vmcnt(" #n ")" ::: "memory")
#define PG8_WAIT_L(n) asm volatile("s_waitcnt lgkmcnt(" #n ")" ::: "memory")
#define PG8_BAR __builtin_amdgcn_s_barrier()
#define PG8_SCHED __builtin_amdgcn_sched_barrier(0)
    Unit cur, nxt; int ui = 0;
    if (!S.next(0, cur)) return;
    f32x4 acc[2][2][4][2];
#pragma unroll
    for (int a = 0; a < 2; ++a)
#pragma unroll
        for (int b = 0; b < 2; ++b)
#pragma unroll
            for (int m = 0; m < 4; ++m)
#pragma unroll
                for (int n = 0; n < 2; ++n) acc[a][b][m][n] = (f32x4){0.f, 0.f, 0.f, 0.f};
    bf16x8 At[4][2], B0[2][2], B1[2][2];
    const char* cA = (const char*)g.A + (size_t)cur.pm * tstep; const char* cB = (const char*)g.Bt + (size_t)cur.pn * tstep;
    S.a_ready(cur);
    if constexpr (SP2) {
        PG8_STAGE(PG8_SB(0, 0), cB, voffB); PG8_STAGE(PG8_SB(0, 1), cB + hstep, voffB); PG8_STAGE(PG8_SA(0, 0), cA, voffA); PG8_STAGE(PG8_SA(0, 1), cA + hstep, voffA);
        if (wr == 1) PG8_BAR;
        PG8_WAIT_V(2); PG8_BAR;
        PG8_STAGE(PG8_SB(1, 0), cB + kstep, voffB); PG8_STAGE(PG8_SA(1, 0), cA + kstep, voffA); PG8_STAGE(PG8_SB(1, 1), cB + hstep + kstep, voffB);
        PG8_WAIT_V(6); PG8_BAR;
    } else {
        PG8_STAGE(PG8_SB(0, 0), cB, voffB); PG8_STAGE(PG8_SA(0, 0), cA, voffA); PG8_STAGE(PG8_SB(0, 1), cB + hstep, voffB); PG8_STAGE(PG8_SA(0, 1), cA + hstep, voffA);
        if (wr == 1) PG8_BAR;
        PG8_WAIT_V(4); PG8_BAR;
        PG8_STAGE(PG8_SB(1, 0), cB + kstep, voffB); PG8_STAGE(PG8_SA(1, 0), cA + kstep, voffA); PG8_STAGE(PG8_SB(1, 1), cB + hstep + kstep, voffB);
        PG8_WAIT_V(6); PG8_BAR;
    }
    for (;;) {
        const bool has_next = S.next(ui + 1, nxt);
        const char* nA = has_next ? (const char*)g.A + (size_t)nxt.pm * tstep : cA; const char* nB = has_next ? (const char*)g.Bt + (size_t)nxt.pn * tstep : cB;
        for (int t = 0; t < nt; t += 2) {
            const bool last = (t == nt - 2);
            const char* a1 = cA + (size_t)(t + 1) * kstep;
            const char* a2 = last ? nA : cA + (size_t)(t + 2) * kstep; const char* b2 = last ? nB : cB + (size_t)(t + 2) * kstep;
            const char* a3 = a2 + kstep; const char* b3 = b2 + kstep;
            if (last && has_next) S.a_ready(nxt);
            if constexpr (SP2) {
            PG8_LDB(B0, 0, 0); PG8_LDB(B1, 0, 1); PG8_SCHED; PG8_LDA(At, 0, 0); PG8_STAGE(PG8_SA(1, 1), a1 + hstep, voffA);
            PG8_WAIT_V(8); PG8_WAIT_L(0); PG8_BAR; PG8_MMA(0, 0, At, B0); PG8_MMA(0, 1, At, B1); PG8_BAR; PG8_SCHED;
            PG8_LDA(At, 0, 1); PG8_STAGE(PG8_SB(0, 0), b2, voffB); PG8_STAGE(PG8_SB(0, 1), b2 + hstep, voffB); PG8_STAGE(PG8_SA(0, 0), a2, voffA);
            PG8_WAIT_V(8); PG8_WAIT_L(0); PG8_BAR; PG8_MMA(1, 0, At, B0); PG8_MMA(1, 1, At, B1); PG8_BAR; PG8_SCHED;
            PG8_LDB(B0, 1, 0); PG8_LDB(B1, 1, 1); PG8_SCHED; PG8_LDA(At, 1, 0); PG8_STAGE(PG8_SA(0, 1), a2 + hstep, voffA);
            PG8_WAIT_V(8); PG8_WAIT_L(0); PG8_BAR; PG8_MMA(0, 0, At, B0); PG8_MMA(0, 1, At, B1); PG8_BAR; PG8_SCHED;
            PG8_LDA(At, 1, 1); PG8_STAGE(PG8_SB(1, 0), b3, voffB); PG8_STAGE(PG8_SB(1, 1), b3 + hstep, voffB); PG8_STAGE(PG8_SA(1, 0), a3, voffA);
            PG8_WAIT_V(8); PG8_WAIT_L(0); PG8_BAR; PG8_MMA(1, 0, At, B0); PG8_MMA(1, 1, At, B1); PG8_BAR; PG8_SCHED;
            } else {
            PG8_LDB(B0, 0, 0); PG8_SCHED; PG8_LDA(At, 0, 0); PG8_STAGE(PG8_SA(1, 1), a1 + hstep, voffA);
            PG8_WAIT_L(8); PG8_BAR; PG8_WAIT_L(0); PG8_MMA(0, 0, At, B0); PG8_BAR; PG8_SCHED;
            PG8_LDB(B1, 0, 1); PG8_STAGE(PG8_SB(0, 0), b2, voffB);
            PG8_BAR; PG8_WAIT_L(0); PG8_MMA(0, 1, At, B1); PG8_BAR;
            PG8_LDA(At, 0, 1); PG8_STAGE(PG8_SA(0, 0), a2, voffA);
            PG8_BAR; PG8_WAIT_L(0); PG8_MMA(1, 0, At, B0); PG8_BAR; PG8_SCHED;
            PG8_STAGE(PG8_SB(0, 1), b2 + hstep, voffB);
            PG8_WAIT_V(6); PG8_BAR; PG8_MMA(1, 1, At, B1); PG8_BAR;
            PG8_LDB(B0, 1, 0); PG8_SCHED; PG8_LDA(At, 1, 0); PG8_STAGE(PG8_SA(0, 1), a2 + hstep, voffA);
            PG8_WAIT_L(8); PG8_BAR; PG8_WAIT_L(0); PG8_MMA(0, 0, At, B0); PG8_BAR; PG8_SCHED;
            PG8_LDB(B1, 1, 1); PG8_STAGE(PG8_SB(1, 0), b3, voffB);
            PG8_BAR; PG8_WAIT_L(0); PG8_MMA(0, 1, At, B1); PG8_BAR;
            PG8_LDA(At, 1, 1); PG8_STAGE(PG8_SA(1, 0), a3, voffA);
            PG8_BAR; PG8_WAIT_L(0); PG8_MMA(1, 0, At, B0); PG8_BAR; PG8_SCHED;
            PG8_STAGE(PG8_SB(1, 1), b3 + hstep, voffB);
            PG8_WAIT_V(6); PG8_BAR; PG8_MMA(1, 1, At, B1); PG8_BAR;
            }
        }
        if constexpr (ALIGN_EPI) { if (wr == 0) PG8_BAR; }
        if constexpr (!Epi::AFTER_DRAIN) { E(acc, cur, wr, wc, fr, fq); S.done(cur); }
        if (!has_next) break;
#pragma unroll
        for (int a = 0; a < 2; ++a)
#pragma unroll
            for (int b = 0; b < 2; ++b)
#pragma unroll
                for (int m = 0; m < 4; ++m)
#pragma unroll
                    for (int n = 0; n < 2; ++n) acc[a][b][m][n] = (f32x4){0.f, 0.f, 0.f, 0.f};
        cur = nxt; cA = nA; cB = nB; ++ui;
        if constexpr (ALIGN_EPI) { if (wr == 1) PG8_BAR; }
    }
    PG8_WAIT_V(0);
    if constexpr (!ALIGN_EPI) { if (wr == 0) PG8_BAR; }
    PG8_BAR;
    if constexpr (Epi::AFTER_DRAIN) { E.fused(acc, cur, wr, wc, fr, fq, lds, wid, lane); S.done(cur); }
#undef PG8_SA
#undef PG8_SB
#undef PG8_STAGE
#undef PG8_LDA
#undef PG8_LDB
#undef PG8_MMA
#undef PG8_WAIT_V
#undef PG8_WAIT_L
#undef PG8_BAR
#undef PG8_SCHED
}
}
namespace pg8 {
typedef float f32x2 __attribute__((ext_vector_type(2)));
__device__ __forceinline__ float silu_f(float v) { return v * __builtin_amdgcn_rcpf(1.0f + __builtin_amdgcn_exp2f(-1.4426950408889634f * v)); }

struct EpiSwiGLU {
    static constexpr bool PERM = true, AFTER_DRAIN = false;
    bf16_t* O; int ldc;
    __device__ __forceinline__ void operator()(const f32x4 (&acc)[2][2][4][2], const Unit& u, int wr, int wc, int fr, int fq) const {
        const int row0 = u.pm * BM + wr * 64 + fr, col0 = u.pn * HALF + wc * 32 + 8 * fq;
#pragma unroll
        for (int ai = 0; ai < 2; ++ai)
#pragma unroll
            for (int m = 0; m < 4; ++m) {
                bf16_t* rowp = O + (size_t)(row0 + ai * HALF + m * 16) * ldc + col0;
                const f32x4 a0 = acc[ai][0][m][0], a1 = acc[ai][0][m][1], g0 = acc[ai][1][m][0], g1 = acc[ai][1][m][1];
                u32x4 w;
                w.x = cvt_pk_bf16(silu_f(a0[0]) * g0[0], silu_f(a0[1]) * g0[1]); w.y = cvt_pk_bf16(silu_f(a0[2]) * g0[2], silu_f(a0[3]) * g0[3]);
                w.z = cvt_pk_bf16(silu_f(a1[0]) * g1[0], silu_f(a1[1]) * g1[1]); w.w = cvt_pk_bf16(silu_f(a1[2]) * g1[2], silu_f(a1[3]) * g1[3]);
                *(u32x4*)rowp = w;
            }
    }
};

struct EpiResid {
    static constexpr bool PERM = false, AFTER_DRAIN = false;
    const float* X; float* Y; const float* gate; int gate_ld; float coef, alpha;
    __device__ __forceinline__ void operator()(const f32x4 (&acc)[2][2][4][2], const Unit& u, int wr, int wc, int fr, int fq) const {
        const int col0 = u.pn * BM + wc * 32 + 4 * fq; const float* gb = gate + (size_t)(u.pm >> 3) * gate_ld + col0;
        f32x4 gv[2][2];
#pragma unroll
        for (int bj = 0; bj < 2; ++bj)
#pragma unroll
            for (int n = 0; n < 2; ++n) gv[bj][n] = *(const f32x4*)(gb + bj * HALF + n * 16) * coef;
#pragma unroll
        for (int ai = 0; ai < 2; ++ai)
#pragma unroll
            for (int m = 0; m < 4; ++m) { const size_t off = (size_t)(u.pm * BM + ai * HALF + wr * 64 + m * 16 + fr) * 1024 + col0;
#pragma unroll
                for (int bj = 0; bj < 2; ++bj)
#pragma unroll
                    for (int n = 0; n < 2; ++n) { const f32x4 xv = *(const f32x4*)(X + off + bj * HALF + n * 16);
                        *(f32x4*)(Y + off + bj * HALF + n * 16) = xv * alpha + gv[bj][n] * acc[ai][bj][m][n]; }
                if (m & 1) asm volatile("" ::: "memory"); }
    }
};

struct EpiInProj {
    static constexpr bool PERM = true, AFTER_DRAIN = false;
    bf16_t *Q, *QI, *K, *KI, *VT, *B4; float* SM; const float *cs, *sn;
    float qscale, wscale;
    __device__ __forceinline__ void rope_store(const f32x4 (&acc)[2][2][4][2], bf16_t* dst, int ld, int colbase, float sc, int row0, int fq) const {
        typedef unsigned u32x2 __attribute__((ext_vector_type(2)));
#pragma unroll
        for (int ai = 0; ai < 2; ++ai)
#pragma unroll
            for (int m = 0; m < 4; ++m) { const int r = row0 + ai * HALF + m * 16;
                bf16_t* p = dst + (size_t)r * ld + colbase + 8 * fq;
#pragma unroll
                for (int n = 0; n < 2; ++n) {
                    const f32x4 c0 = *(const f32x4*)(cs + (size_t)r * 32 + 8 * fq + 4 * n), s0 = *(const f32x4*)(sn + (size_t)r * 32 + 8 * fq + 4 * n);
                    const f32x4 x0 = acc[ai][0][m][n], y0 = acc[ai][1][m][n];
                    const f32x4 o0 = (x0 * c0 - y0 * s0) * sc, p0 = (y0 * c0 + x0 * s0) * sc;
                    u32x2 w; w.x = cvt_pk_bf16(o0[0], o0[1]); w.y = cvt_pk_bf16(o0[2], o0[3]); *(u32x2*)(p + 4 * n) = w;
                    w.x = cvt_pk_bf16(p0[0], p0[1]); w.y = cvt_pk_bf16(p0[2], p0[3]); *(u32x2*)(p + 32 + 4 * n) = w;
                    asm volatile("" ::: "memory"); } }
    }
    __device__ __forceinline__ void operator()(const f32x4 (&acc)[2][2][4][2], const Unit& u, int wr, int wc, int fr, int fq) const {
        const int row0 = u.pm * BM + wr * 64 + fr; const int pn = u.pn;
        if (pn < 2) { rope_store(acc, Q, 512, ((pn & 1) * 4 + wc) * 64, qscale, row0, fq); }
        else if (pn < 4) { rope_store(acc, QI, 512, ((pn & 1) * 4 + wc) * 64, 1.0f, row0, fq); }
        else if (pn == 4) {
            if (wc == 0) rope_store(acc, K, 64, 0, 1.0f, row0, fq);
            else if (wc == 1) rope_store(acc, KI, 64, 0, 1.0f, row0, fq);
            else if (wc == 2) {
#pragma unroll
                for (int ai = 0; ai < 2; ++ai)
#pragma unroll
                    for (int m = 0; m < 4; ++m) { bf16_t* rowp = VT + (size_t)(row0 + ai * HALF + m * 16) * 64 + 8 * fq;
#pragma unroll
                        for (int bj = 0; bj < 2; ++bj) { const f32x4 v0 = acc[ai][bj][m][0], v1 = acc[ai][bj][m][1]; u32x4 w;
                            w.x = cvt_pk_bf16(v0[0], v0[1]); w.y = cvt_pk_bf16(v0[2], v0[3]); w.z = cvt_pk_bf16(v1[0], v1[1]); w.w = cvt_pk_bf16(v1[2], v1[3]);
                            *(u32x4*)(rowp + bj * 32) = w; } }
            } else {
                if (fq < 2) {
#pragma unroll
                    for (int ai = 0; ai < 2; ++ai)
#pragma unroll
                        for (int m = 0; m < 4; ++m) { const int r = row0 + ai * HALF + m * 16; const float s = (fq == 0) ? wscale : 1.0f;
                            *(f32x4*)(SM + (size_t)r * 16 + 8 * fq) = acc[ai][0][m][0] * s; *(f32x4*)(SM + (size_t)r * 16 + 8 * fq + 4) = acc[ai][0][m][1] * s; }
                }
            }
        } else {
            const int col0 = (pn - 5) * BM + wc * 32 + 8 * fq;
#pragma unroll
            for (int ai = 0; ai < 2; ++ai)
#pragma unroll
                for (int m = 0; m < 4; ++m) { bf16_t* rowp = B4 + (size_t)(row0 + ai * HALF + m * 16) * 2048 + col0;
#pragma unroll
                    for (int bj = 0; bj < 2; ++bj) { const f32x4 v0 = acc[ai][bj][m][0], v1 = acc[ai][bj][m][1]; u32x4 w;
                        w.x = cvt_pk_bf16(v0[0], v0[1]); w.y = cvt_pk_bf16(v0[2], v0[3]); w.z = cvt_pk_bf16(v1[0], v1[1]); w.w = cvt_pk_bf16(v1[2], v1[3]);
                        *(u32x4*)(rowp + bj * HALF) = w; } }
        }
    }
};
}
namespace cg = cooperative_groups;
#define LAS __attribute__((address_space(3)))
typedef unsigned short bf16;
typedef unsigned v4u __attribute__((ext_vector_type(4)));
typedef unsigned v2u __attribute__((ext_vector_type(2)));
typedef float f32x4 __attribute__((ext_vector_type(4)));
typedef float f32x16 __attribute__((ext_vector_type(16)));
typedef short bf16x8 __attribute__((ext_vector_type(8)));
typedef short bf16x4 __attribute__((ext_vector_type(4)));

constexpr int NWAVES = 8, NTHREADS = 512;
constexpr int BATCH = 16, SEQ = 2048, D = 1024, T = BATCH * SEQ, FF = 2816, NMOD = 9216;
constexpr int NIN = 3280, NINP = 3328;
constexpr float LN_EPS = 1e-5f, RMS_EPS = 1e-6f;
constexpr float ALPHA = 1.189207115002721f;
constexpr float LOG2E = 1.4426950408889634f;
constexpr float QSCALE = 0.125f * LOG2E;

constexpr size_t MiB = 1u << 20;
constexpr size_t WS_CTL = 0, CTL_ZERO_BYTES = 64 * 1024;
constexpr size_t WS_MOD = 1 * MiB, WS_COS = 2 * MiB, WS_SIN = 6 * MiB;
constexpr size_t WS_W13A = 10 * MiB, WS_W2A = 21 * MiB, WS_W13B = 27 * MiB, WS_W2B = 38 * MiB, WS_WIN = 44 * MiB, WS_WOUT = 51 * MiB;
constexpr size_t WS_SM = 53 * MiB, WS_K = 55 * MiB, WS_KI = 59 * MiB, WS_VT = 63 * MiB, WS_MASK = 67 * MiB, WS_QI = 75 * MiB, WS_AQK = 107 * MiB, WS_GL = 123 * MiB;
constexpr size_t WS_U = 124 * MiB;
constexpr size_t WS_X = 188 * MiB;
constexpr size_t WS_H = 316 * MiB;
constexpr size_t WS_B4 = WS_H, WS_Q = WS_H + 128 * MiB;
constexpr size_t WS_END = 492 * MiB;
constexpr int CW_QUEUE = 64;

__device__ __forceinline__ unsigned f2bf(float f) { unsigned u = __builtin_bit_cast(unsigned, f); return (u + 0x7fffu + ((u >> 16) & 1u)) >> 16; }
__device__ __forceinline__ unsigned pk2(float lo, float hi) { return f2bf(lo) | (f2bf(hi) << 16); }
__device__ __forceinline__ float bf2f(unsigned short h) { return __builtin_bit_cast(float, (unsigned)h << 16); }
__device__ __forceinline__ float wave_sum(float v) {
#pragma unroll
    for (int o = 1; o < 64; o <<= 1) v += __shfl_xor(v, o);
    return v;
}
#define LDS_WAIT() asm volatile("s_waitcnt lgkmcnt(0)" ::: "memory")

struct Args {
    const float *x, *c; const int* pos; const float *w_ada, *b_ada, *f1w1, *f1w3, *f1w2, *ln1g, *ln1b, *w_in, *conv_w, *a_log, *dt_bias, *dn_g, *w_out, *ln2g, *ln2b, *f2w1, *f2w3, *f2w2, *ln3g, *ln3b;
    float* out; unsigned char* ws;
};

__device__ __forceinline__ void p0_mod(const Args& A, LAS unsigned char* lds, int tid, int wave, int lane, int bid, int G) {
    LAS float* sc = (LAS float*)lds;
    LAS float* red = (LAS float*)(lds + 65536);
    float* mod = (float*)(A.ws + WS_MOD);
    bool have_sc = false;
    for (int task = bid; task < NMOD / 32; task += G) {
        if (!have_sc) { for (int i = tid; i < 16 * 1024; i += NTHREADS) { const float v = A.c[i]; sc[i] = v / (1.0f + __expf(-v)); } have_sc = true; __syncthreads(); }
        const int col = lane & 31, half = lane >> 5, j0 = task * 32;
        float acc[16];
#pragma unroll
        for (int b = 0; b < 16; ++b) acc[b] = 0.f;
#pragma unroll 4
        for (int i = 0; i < 64; ++i) { const int k = wave * 128 + 2 * i + half; const float wv = A.w_ada[(size_t)k * NMOD + j0 + col];
#pragma unroll
            for (int b = 0; b < 16; ++b) acc[b] += sc[b * 1024 + k] * wv; }
#pragma unroll
        for (int b = 0; b < 16; ++b) red[((wave * 2 + half) * 16 + b) * 32 + col] = acc[b];
        __syncthreads();
        { const int b = tid >> 5, cc = tid & 31; float s = A.b_ada[j0 + cc];
#pragma unroll
            for (int p = 0; p < 16; ++p) s += red[(p * 16 + b) * 32 + cc];
            mod[b * NMOD + j0 + cc] = s; }
        __syncthreads();
    }
}

template <class F>
__device__ __forceinline__ void transpose_item(const float* W, int K, int N, bf16* WT, F dstrow, LAS float* scr, int item, int lane) {
    const int nblk = (N + 31) / 32, kb = item / nblk, nb = item % nblk, k0 = 64 * kb, n0 = 32 * nb;
    const bool nok = (n0 + (lane & 31)) < N;
#pragma unroll 8
    for (int i = 0; i < 32; ++i) { const int kk = 2 * i + (lane >> 5); scr[kk * 33 + (lane & 31)] = nok ? W[(size_t)(k0 + kk) * N + n0 + (lane & 31)] : 0.f; }
    LDS_WAIT(); asm volatile("" ::: "memory");
    const int c = lane & 7;
#pragma unroll
    for (int j = 0; j < 4; ++j) { const int n = (lane >> 3) + 8 * j; const LAS float* s = scr + (8 * c) * 33 + n;
        v4u o; o.x = pk2(s[0 * 33], s[1 * 33]); o.y = pk2(s[2 * 33], s[3 * 33]); o.z = pk2(s[4 * 33], s[5 * 33]); o.w = pk2(s[6 * 33], s[7 * 33]);
        const int dr = (n0 + n < N) ? dstrow(n0 + n) : -1;
        if (dr >= 0) *(v4u*)(WT + (size_t)dr * K + k0 + 8 * c) = o; }
    LDS_WAIT(); asm volatile("" ::: "memory");
}
__device__ __forceinline__ int win_dst(int n) {
    if (n < 512) { const int head = n >> 6, d = n & 63; return 256 * (head >> 2) + 128 * (d >> 5) + 32 * (head & 3) + (d & 31); }
    if (n < 576) { const int d = n - 512; return 1024 + 128 * (d >> 5) + (d & 31); }
    if (n < 640) { const int d = n - 576; return 1024 + 128 * (d >> 5) + 64 + (d & 31); }
    if (n < 1152) { const int j = n - 640, head = j >> 6, d = j & 63; return 256 * (2 + (head >> 2)) + 128 * (d >> 5) + 32 * (head & 3) + (d & 31); }
    if (n < 1216) { const int d = n - 1152; return 1024 + 128 * (d >> 5) + 32 + (d & 31); }
    if (n < 1224) return 1024 + 96 + (n - 1216);
    if (n < 3272) return 1280 + (n - 1224);
    if (n < 3276) return 1024 + 96 + 8 + (n - 3272);
    return 1024 + 96 + 12 + (n - 3276);
}
__device__ __forceinline__ void p0_weights(const Args& A, LAS unsigned char* lds, int wave, int lane, int bid, int G) {
    LAS float* scr = (LAS float*)(lds + wave * 16384);
    const int gw = bid * NWAVES + wave, NGW = G * NWAVES;
    constexpr int I_13 = (D / 64) * (FF / 32), I_2 = (FF / 64) * (D / 32), I_IN = (D / 64) * ((NIN + 31) / 32), I_OUT = (D / 64) * (D / 32);
    constexpr int NITEMS = 4 * I_13 + 2 * I_2 + I_IN + I_OUT;
    bf16* W13A = (bf16*)(A.ws + WS_W13A); bf16* W2A = (bf16*)(A.ws + WS_W2A); bf16* W13B = (bf16*)(A.ws + WS_W13B); bf16* W2B = (bf16*)(A.ws + WS_W2B);
    bf16* WIN = (bf16*)(A.ws + WS_WIN); bf16* WOUT = (bf16*)(A.ws + WS_WOUT);
    auto d1 = [](int n) { return (n >> 7) * 256 + (n & 127); };
    auto d3 = [](int n) { return (n >> 7) * 256 + 128 + (n & 127); };
    auto id = [](int n) { return n; };
    for (int it = gw; it < NITEMS; it += NGW) {
        int r = it;
        if (r < I_13) { transpose_item(A.f1w1, D, FF, W13A, d1, scr, r, lane); continue; } r -= I_13;
        if (r < I_13) { transpose_item(A.f1w3, D, FF, W13A, d3, scr, r, lane); continue; } r -= I_13;
        if (r < I_13) { transpose_item(A.f2w1, D, FF, W13B, d1, scr, r, lane); continue; } r -= I_13;
        if (r < I_13) { transpose_item(A.f2w3, D, FF, W13B, d3, scr, r, lane); continue; } r -= I_13;
        if (r < I_2) { transpose_item(A.f1w2, FF, D, W2A, id, scr, r, lane); continue; } r -= I_2;
        if (r < I_2) { transpose_item(A.f2w2, FF, D, W2B, id, scr, r, lane); continue; } r -= I_2;
        if (r < I_IN) { transpose_item(A.w_in, D, NIN, WIN, [](int n) { return win_dst(n); }, scr, r, lane); continue; } r -= I_IN;
        transpose_item(A.w_out, D, D, WOUT, id, scr, r, lane);
    }
    for (int i = gw * 64 + lane; i < 48 * 128; i += NGW * 64) { const int rr = i >> 7, ch = i & 127; const int row = rr < 16 ? 1136 + rr : 1248 + (rr - 16);
        *(v4u*)(WIN + (size_t)row * D + ch * 8) = (v4u){0u, 0u, 0u, 0u}; }
}
__device__ __forceinline__ void p0_rope(const Args& A, int tid, int bid, int G) {
    float* cs = (float*)(A.ws + WS_COS); float* sn = (float*)(A.ws + WS_SIN);
    for (int i = bid * NTHREADS + tid; i < T * 32; i += G * NTHREADS) {
        const int t = i >> 5, j = i & 31;
        const float inv = (float)exp2(-(double)j * (13.287712379549449 / 32.0));
        const float ang = (float)A.pos[t] * inv;
        const double x = (double)ang; const double q = rint(x * 0.6366197723675814); const double y = x - q * 1.5707963267948966;
        const double y2 = y * y;
        const double sy = y * (1.0 + y2 * (-1.0 / 6 + y2 * (1.0 / 120 + y2 * (-1.0 / 5040 + y2 * (1.0 / 362880 + y2 * (-1.0 / 39916800 + y2 * (1.0 / 6227020800.0)))))));
        const double cy = 1.0 + y2 * (-0.5 + y2 * (1.0 / 24 + y2 * (-1.0 / 720 + y2 * (1.0 / 40320 + y2 * (-1.0 / 3628800 + y2 * (1.0 / 479001600 + y2 * (-1.0 / 87178291200.0)))))));
        const int qi = ((int)q) & 3;
        const double sv = (qi == 0) ? sy : (qi == 1) ? cy : (qi == 2) ? -sy : -cy;
        const double cv = (qi == 0) ? cy : (qi == 1) ? -sy : (qi == 2) ? -cy : sy;
        cs[i] = (float)cv; sn[i] = (float)sv;
    }
}
__device__ __forceinline__ void p_modulate_rows(const float* X, bf16* U, const float* mod, int sh_off, int sc_off, int wave, int lane, int bid, int G) {
    const int gw = bid * NWAVES + wave, NGW = G * NWAVES;
    for (int m = gw; m < T; m += NGW) { const int b = m >> 11; const float* mb = mod + (size_t)b * NMOD;
        const f32x4* xr = (const f32x4*)(X + (size_t)m * D) + lane; unsigned long long* o8 = (unsigned long long*)(U + (size_t)m * D) + lane;
#pragma unroll
        for (int j = 0; j < 4; ++j) { const f32x4 v = xr[64 * j]; const f32x4 sh = *((const f32x4*)(mb + sh_off) + lane + 64 * j), sc = *((const f32x4*)(mb + sc_off) + lane + 64 * j);
            const f32x4 u = v * (sc + 1.0f) + sh; o8[64 * j] = (unsigned long long)pk2(u.x, u.y) | ((unsigned long long)pk2(u.z, u.w) << 32); } }
}
__device__ __forceinline__ void p_ln_rows(const float* Y, float* XO, bf16* U, const float* g, const float* bb, const float* mod, int sh_off, int sc_off, int wave, int lane, int bid, int G) {
    const int gw = bid * NWAVES + wave, NGW = G * NWAVES;
    for (int m = gw; m < T; m += NGW) { const int b = m >> 11; const float* mb = mod + (size_t)b * NMOD;
        const f32x4* yr = (const f32x4*)(Y + (size_t)m * D) + lane;
        f32x4 v[4]; float s = 0.f;
#pragma unroll
        for (int j = 0; j < 4; ++j) { v[j] = yr[64 * j]; s += (v[j].x + v[j].y) + (v[j].z + v[j].w); }
        const float mean = wave_sum(s) * (1.f / D); float s2 = 0.f;
#pragma unroll
        for (int j = 0; j < 4; ++j) { v[j] = v[j] - mean; s2 += (v[j].x * v[j].x + v[j].y * v[j].y) + (v[j].z * v[j].z + v[j].w * v[j].w); }
        const float rstd = 1.f / sqrtf(wave_sum(s2) * (1.f / D) + LN_EPS);
#pragma unroll
        for (int j = 0; j < 4; ++j) { const f32x4 gg = *((const f32x4*)g + lane + 64 * j), be = *((const f32x4*)bb + lane + 64 * j);
            const f32x4 xo = v[j] * rstd * gg + be;
            if (XO) *((f32x4*)(XO + (size_t)m * D) + lane + 64 * j) = xo;
            if (U) { const f32x4 sh = *((const f32x4*)(mb + sh_off) + lane + 64 * j), sc = *((const f32x4*)(mb + sc_off) + lane + 64 * j);
                const f32x4 u = xo * (sc + 1.0f) + sh; *((unsigned long long*)(U + (size_t)m * D) + lane + 64 * j) = (unsigned long long)pk2(u.x, u.y) | ((unsigned long long)pk2(u.z, u.w) << 32); } } }
}
#define RLX_AGENT __ATOMIC_RELAXED, __HIP_MEMORY_SCOPE_AGENT
struct XcdBarrier { unsigned* ctr; unsigned epoch; unsigned G; };
__device__ __forceinline__ void xcd_barrier(XcdBarrier& b) {
    asm volatile("s_waitcnt vmcnt(0)" ::: "memory");
    __syncthreads();
    b.epoch += 1u;
    if (threadIdx.x == 0) {
        __builtin_amdgcn_fence(__ATOMIC_RELEASE, "agent");
        asm volatile("s_waitcnt vmcnt(0)" ::: "memory");
        __hip_atomic_fetch_add(b.ctr, 1u, __ATOMIC_RELAXED, __HIP_MEMORY_SCOPE_AGENT);
        const unsigned want = b.epoch * b.G;
        while (__hip_atomic_load(b.ctr, __ATOMIC_RELAXED, __HIP_MEMORY_SCOPE_AGENT) < want) __builtin_amdgcn_s_sleep(2);
#ifdef BAR_DELAY
        for (int i = 0; i < BAR_DELAY; ++i) __builtin_amdgcn_s_sleep(127);
#endif
        __builtin_amdgcn_fence(__ATOMIC_ACQUIRE, "agent");
        asm volatile("s_waitcnt vmcnt(0)" ::: "memory");
    }
    __syncthreads();
}
#include <hip/hip_bf16.h>
#include <cmath>
namespace attn_body {
using bf16=__hip_bfloat16;
using bf16x8=__attribute__((ext_vector_type(8)))short;
using s16x4=__attribute__((ext_vector_type(4)))short;
using f32x16=__attribute__((ext_vector_type(16)))float;
using u32x4=__attribute__((ext_vector_type(4)))unsigned;
constexpr int BATCH=16,NHEAD=8,SEQ=2048,D=64,QP=512,KP=64,OP=1024;
constexpr int NW=8,QBLK=32,QB=QBLK*NW,KVBLK=64,NQB=SEQ/QB;
constexpr int ATTN_UNIT_ROWS=QB;
__device__ __forceinline__ int crow(int r,int hi){return (r&3)+8*(r>>2)+4*hi;}
#define SBAR() __builtin_amdgcn_sched_barrier(0)
typedef unsigned v2u_t __attribute__((ext_vector_type(2)));
__device__ __forceinline__ void kmask(f32x16&p0,f32x16&p1,v2u_t mw,int hi){
  const unsigned w0=mw.x>>(4*hi),w1=mw.y>>(4*hi);
  #pragma unroll
  for(int r=0;r<16;++r){const int c=(r&3)+8*(r>>2);
    const int m0=((int)(w0<<(31-c)))>>31,m1=((int)(w1<<(31-c)))>>31;
    const float a0=p0[r],a1=p1[r];
    const int i0=(__float_as_int(a0)&m0)|(~m0&(int)0xff800000),i1=(__float_as_int(a1)&m1)|(~m1&(int)0xff800000);
    p0[r]=__int_as_float(i0);p1[r]=__int_as_float(i1);}
}

constexpr int NSLOT=3, SLOTB=8192;
constexpr int LDS_K=0, LDS_V=NSLOT*SLOTB, LDS_WS=2*NSLOT*SLOTB, LDS_OST=LDS_WS+NW*64*4, LDS_BYTES=LDS_OST+NW*4096;
constexpr float C2=0.125f*1.4426950408889634f;
__device__ __forceinline__ void glds16(const void*gsrc,unsigned lds_dst){unsigned keep;
  asm volatile("s_mov_b32 %0, m0\n\ts_mov_b32 m0, %2\n\ts_nop 0\n\tglobal_load_lds_dwordx4 %1, off\n\ts_mov_b32 m0, %0":"=&s"(keep):"v"(gsrc),"s"(lds_dst):"memory");}
__device__ __forceinline__ float max3f(float a,float b,float c){float r;asm("v_max3_f32 %0, %1, %2, %3":"=v"(r):"v"(a),"v"(b),"v"(c));return r;}
__device__ __forceinline__ float max2f(float a,float b){float r;asm("v_max_f32_e32 %0, %1, %2":"=v"(r):"v"(a),"v"(b));return r;}
__device__ __forceinline__ float fadd_s(float a,float b){float r;asm("v_add_f32_e32 %0, %1, %2":"=v"(r):"v"(a),"v"(b));return r;}
__device__ __forceinline__ float fsub_s(float a,float b){float r;asm("v_sub_f32_e32 %0, %1, %2":"=v"(r):"v"(a),"v"(b));return r;}
typedef float f32x2_t __attribute__((ext_vector_type(2))); typedef __bf16 bf16x2_t __attribute__((ext_vector_type(2)));
__device__ __forceinline__ unsigned cvtpk_s(float lo,float hi){f32x2_t v={lo,hi};bf16x2_t b=__builtin_convertvector(v,bf16x2_t);return __builtin_bit_cast(unsigned,b);}
#define WAIT_BAR(N) asm volatile("s_waitcnt vmcnt(" #N ") lgkmcnt(0)\n\ts_barrier":::"memory")

__device__ __forceinline__ void qkt(f32x16&p0,f32x16&p1,const char*Kslot,const bf16x8*qr,const f32x16&negm,int r32,int hi){
  const char*kb=Kslot+hi*1024+r32*16;
  #pragma unroll
  for(int d0=0;d0<4;++d0){
    const bf16x8 b0=*reinterpret_cast<const bf16x8*>(kb+d0*2048);
    const bf16x8 b1=*reinterpret_cast<const bf16x8*>(kb+d0*2048+512);
    if(d0==0){p0=__builtin_amdgcn_mfma_f32_32x32x16_bf16(b0,qr[0],negm,0,0,0);p1=__builtin_amdgcn_mfma_f32_32x32x16_bf16(b1,qr[0],negm,0,0,0);}
    else{p0=__builtin_amdgcn_mfma_f32_32x32x16_bf16(b0,qr[d0],p0,0,0,0);p1=__builtin_amdgcn_mfma_f32_32x32x16_bf16(b1,qr[d0],p1,0,0,0);}}
}
typedef __attribute__((address_space(3))) const char* lds_cptr;
typedef short v4i16_t __attribute__((ext_vector_type(4)));
__device__ __forceinline__ void kload8(bf16x8*kf,lds_cptr kp){
  kf[0]=*(const __attribute__((address_space(3))) bf16x8*)(kp);      kf[1]=*(const __attribute__((address_space(3))) bf16x8*)(kp+512);
  kf[2]=*(const __attribute__((address_space(3))) bf16x8*)(kp+2048); kf[3]=*(const __attribute__((address_space(3))) bf16x8*)(kp+2560);
  kf[4]=*(const __attribute__((address_space(3))) bf16x8*)(kp+4096); kf[5]=*(const __attribute__((address_space(3))) bf16x8*)(kp+4608);
  kf[6]=*(const __attribute__((address_space(3))) bf16x8*)(kp+6144); kf[7]=*(const __attribute__((address_space(3))) bf16x8*)(kp+6656);
}
__device__ __forceinline__ void kload2(bf16x8*kf,lds_cptr kp,int j){ kf[2*j]=*(const __attribute__((address_space(3))) bf16x8*)(kp+j*2048); kf[2*j+1]=*(const __attribute__((address_space(3))) bf16x8*)(kp+j*2048+512); }
__device__ __forceinline__ s16x4 vtr(lds_cptr p){ return __builtin_bit_cast(s16x4,__builtin_amdgcn_ds_read_tr16_b64_v4i16((__attribute__((address_space(3))) v4i16_t*)p)); }
__device__ __forceinline__ float rowmax(const f32x16&p0,const f32x16&p1){
  float a=max3f(p0[0],p0[1],p1[0]),b=max3f(p0[2],p0[3],p1[1]);a=max3f(a,p1[2],p1[3]);
  #pragma unroll
  for(int r=4;r<16;r+=4){a=max3f(a,p0[r],p0[r+1]);b=max3f(b,p0[r+2],p0[r+3]);a=max3f(a,p1[r],p1[r+1]);b=max3f(b,p1[r+2],p1[r+3]);}
  const float m=max2f(a,b);
  auto rr=__builtin_amdgcn_permlane32_swap(__float_as_uint(m),__float_as_uint(m),false,false);
  return max2f(__uint_as_float(rr[0]),__uint_as_float(rr[1]));
}
__device__ __forceinline__ void pv(f32x16*o,int vb,bf16x8 pa0,bf16x8 pa1,bf16x8 pa2,bf16x8 pa3){
  #pragma unroll
  for(int d0=0;d0<2;++d0){s16x4 lo[4],hi[4];
    #pragma unroll
    for(int ks=0;ks<4;++ks){
      asm volatile("ds_read_b64_tr_b16 %0,%1 offset:%c2":"=&v"(lo[ks]):"v"(vb),"i"(d0*4096+ks*1024):"memory");
      asm volatile("ds_read_b64_tr_b16 %0,%1 offset:%c2":"=&v"(hi[ks]):"v"(vb),"i"(d0*4096+ks*1024+512):"memory");}
    asm volatile("s_waitcnt lgkmcnt(0)":::"memory");SBAR();
    #define PK(k) (bf16x8){lo[k][0],lo[k][1],lo[k][2],lo[k][3],hi[k][0],hi[k][1],hi[k][2],hi[k][3]}
    o[d0]=__builtin_amdgcn_mfma_f32_32x32x16_bf16(pa0,PK(0),o[d0],0,0,0);
    o[d0]=__builtin_amdgcn_mfma_f32_32x32x16_bf16(pa1,PK(1),o[d0],0,0,0);
    o[d0]=__builtin_amdgcn_mfma_f32_32x32x16_bf16(pa2,PK(2),o[d0],0,0,0);
    o[d0]=__builtin_amdgcn_mfma_f32_32x32x16_bf16(pa3,PK(3),o[d0],0,0,0);
    #undef PK
  }
}

#ifndef ATTN_STORE16
#define ATTN_STORE16(p,v) (*(u32x4*)(p)=(v))
#endif
template<int THRL> __device__ __forceinline__ void attn_unit(int b,int h,int qb,const bf16*Q,const bf16*K,const bf16*V,bf16*O,const unsigned*MASK,char*shm){
  const int tid=threadIdx.x,lane=tid&63,r32=lane&31,hi=lane>>5; const int wid=__builtin_amdgcn_readfirstlane(tid>>6);
  const long rowbase=(long)b*SEQ; const int q0=qb*QB;
  const bf16*Qw=Q+(rowbase+q0+wid*QBLK)*QP+h*D;
  const bf16*Kh=K+rowbase*KP,*Vh=V+rowbase*KP;
  const unsigned lds0=(unsigned)(uintptr_t)shm;
  float*wsf=(float*)(shm+LDS_WS)+wid*64;
  const bf16*ksrc=Kh+(long)lane*KP+wid*8;
  const bf16*vsrc=Vh+(long)(16*(wid&3)+(lane>>2))*KP+(wid>>2)*32+(lane&3)*8;
  const unsigned kdst=lds0+LDS_K+wid*1024, vdst=lds0+LDS_V+wid*1024;
  #define DMA_K(t,slot) glds16(ksrc+(long)(t)*KVBLK*KP,(unsigned)__builtin_amdgcn_readfirstlane(kdst+(slot)))
  #define DMA_V(t,slot) glds16(vsrc+(long)(t)*KVBLK*KP,(unsigned)__builtin_amdgcn_readfirstlane(vdst+(slot)))
  const int vb0=(int)(lds0+LDS_V)+((lane>>4)&1)*32+(lane&3)*8+(4*hi+((lane&15)>>2))*64;
  const char*Kbase=shm+LDS_K; bf16x8 kf[8];
  const lds_cptr shm3=(lds_cptr)shm; const lds_cptr kp0=shm3+LDS_K+hi*1024+r32*16; const lds_cptr vp0=shm3+LDS_V+((lane>>4)&1)*32+(lane&3)*8+(4*hi+((lane&15)>>2))*64;
  const int NT=(q0+QB)/KVBLK;
  DMA_K(0,0);DMA_V(0,0);DMA_K(1,SLOTB);
  bf16x8 qr[4];
  #pragma unroll
  for(int d0=0;d0<4;++d0)qr[d0]=*reinterpret_cast<const bf16x8*>(&Qw[(long)r32*QP+d0*16+hi*8]);
  float mhat=0.f,l_reg=0.f;f32x16 o[2];o[0]=f32x16{};o[1]=f32x16{};f32x16 negm=f32x16{};asm volatile("":"+v"(negm));
  const unsigned*mptr=MASK+(rowbase+q0+wid*QBLK+r32)*64; v2u_t mw_nxt=*(const v2u_t*)mptr;
  #define CMASK(P0,P1,t) do{ const v2u_t mw_=mw_nxt; { const int tn_=((t)+1<NT)?(t)+1:(NT-1); mw_nxt=*(const v2u_t*)(mptr+2*tn_); } kmask(P0,P1,mw_,hi); }while(0)
  bool resc=false;
  #define START(P0,P1) do{ const float rm=rowmax(P0,P1); resc=false; \
    { const float dl=max2f(rm,-60.f); mhat=fadd_s(mhat,dl); \
      _Pragma("unroll") for(int r=0;r<16;++r){P0[r]=fsub_s(P0[r],dl);P1[r]=fsub_s(P1[r],dl);} \
      _Pragma("unroll") for(int r=0;r<16;++r)negm[r]=-mhat; asm volatile("":"+v"(negm)); } \
    _Pragma("unroll") for(int r=0;r<16;++r)P0[r]=__builtin_amdgcn_exp2f(P0[r]); }while(0)
  #define RESC() do{ if(resc){ asm volatile("s_waitcnt lgkmcnt(0)":::"memory"); \
      _Pragma("unroll") for(int d_=0;d_<2;++d_) _Pragma("unroll") for(int r=0;r<16;++r)o[d_][r]*=wsf[crow(r,hi)]; } }while(0)
  f32x16 pA0,pA1,pB0,pB1;
  int sl_prev=0,sl_cur=0,sl_next=SLOTB;
  #define ROT() do{sl_prev=sl_cur;sl_cur=sl_next;sl_next=(sl_next==(NSLOT-1)*SLOTB)?0:sl_next+SLOTB;}while(0)
  DMA_K(2,2*SLOTB);
  WAIT_BAR(3);
  qkt(pA0,pA1,Kbase,qr,negm,r32,hi);asm volatile("s_nop 15\n\ts_nop 7":"+v"(pA0),"+v"(pA1));CMASK(pA0,pA1,0);
  START(pA0,pA1);
  _Pragma("unroll") for(int r=0;r<16;++r)pA1[r]=__builtin_amdgcn_exp2f(pA1[r]);
  WAIT_BAR(0);
  DMA_K(3,0);DMA_V(1,SLOTB);
  ROT();
  kload8(kf,kp0+sl_cur);
  WAIT_BAR(2);
  s16x4 vlo[8],vhi[8]; u32x4 pw0,pw1,pw2,pw3;
  #define PKW(P,B) cvtpk_s(P[B],P[B+1])
  #define PAF(k) __builtin_bit_cast(bf16x8,pw##k)
  #define VFR(i) (bf16x8){vlo[i][0],vlo[i][1],vlo[i][2],vlo[i][3],vhi[i][0],vhi[i][1],vhi[i][2],vhi[i][3]}
  #define PIN(x) asm volatile("":"+v"(x))
  #define MX3(a,b,c) __builtin_fmaxf(__builtin_fmaxf((a),(b)),(c))
  #define GAPA(MF,A0,A1,A2,A3,W0,W1,PW) do{ MF; sacc+=A0; sacc+=A1; sacc+=A2; sacc+=A3; PIN(sacc); W0; W1; PIN(PW); SBAR(); }while(0)
  #define EX(v) __builtin_amdgcn_exp2f(v)
  #define GAPB(MF,X,B) do{ MF; X[B]=EX(X[B]); X[B+1]=EX(X[B+1]); X[B+2]=EX(X[B+2]); X[B+3]=EX(X[B+3]); PIN(X); SBAR(); }while(0)
  #define VRD(i) do{ vlo[i]=vtr(vp_+(((i)>>2)*4096+((i)&3)*1024)); vhi[i]=vtr(vp_+(((i)>>2)*4096+((i)&3)*1024+512)); }while(0)
  #define KRD(G,j) do{ if(G){ kload2(kf,kp0+sl_next,j); SBAR(); } }while(0)
  #define STEP(C0,C1,P0,P1,t,GK,GV,GL) do{ SBAR(); \
    const lds_cptr vp_=vp0+sl_prev; \
    VRD(0); SBAR(); float sacc=(P0[0]+P0[1]); \
    GAPA(C0=__builtin_amdgcn_mfma_f32_32x32x16_bf16(kf[0],qr[0],negm,0,0,0), P0[2],P0[3],P0[4],P0[5],     pw0[0]=PKW(P0,0), pw0[1]=PKW(P0,2), pw0); \
    VRD(4); SBAR(); GAPA(C1=__builtin_amdgcn_mfma_f32_32x32x16_bf16(kf[1],qr[0],negm,0,0,0), P0[6],P0[7],P0[8],P0[9],     pw0[2]=PKW(P0,4), pw0[3]=PKW(P0,6), pw0); \
    VRD(1); SBAR(); GAPA(C0=__builtin_amdgcn_mfma_f32_32x32x16_bf16(kf[2],qr[1],C0,0,0,0),   P0[10],P0[11],P0[12],P0[13], pw1[0]=PKW(P0,8), pw1[1]=PKW(P0,10), pw1); \
    VRD(5); SBAR(); GAPA(C1=__builtin_amdgcn_mfma_f32_32x32x16_bf16(kf[3],qr[1],C1,0,0,0),   P0[14],P0[15],P1[0],P1[1],   pw1[2]=PKW(P0,12),pw1[3]=PKW(P0,14), pw1); \
    VRD(2); SBAR(); GAPA(C0=__builtin_amdgcn_mfma_f32_32x32x16_bf16(kf[4],qr[2],C0,0,0,0),   P1[2],P1[3],P1[4],P1[5],     pw2[0]=PKW(P1,0), pw2[1]=PKW(P1,2), pw2); \
    VRD(6); SBAR(); GAPA(C1=__builtin_amdgcn_mfma_f32_32x32x16_bf16(kf[5],qr[2],C1,0,0,0),   P1[6],P1[7],P1[8],P1[9],     pw2[2]=PKW(P1,4), pw2[3]=PKW(P1,6), pw2); \
    VRD(3); SBAR(); GAPA(C0=__builtin_amdgcn_mfma_f32_32x32x16_bf16(kf[6],qr[3],C0,0,0,0),   P1[10],P1[11],P1[12],P1[13], pw3[0]=PKW(P1,8), pw3[1]=PKW(P1,10), pw3); \
    VRD(7); SBAR(); GAPA(C1=__builtin_amdgcn_mfma_f32_32x32x16_bf16(kf[7],qr[3],C1,0,0,0),   P1[14],P1[15],0.f,0.f,       pw3[2]=PKW(P1,12),pw3[3]=PKW(P1,14), pw3); \
    l_reg+=sacc; \
    if(GK){DMA_K((t)+3,sl_cur);} if(GV){DMA_V((t)+1,sl_next);} \
    CMASK(C0,C1,t); \
    { float a=MX3(C0[0],C0[1],C1[0]),b=MX3(C0[2],C0[3],C1[1]); a=MX3(a,C1[2],C1[3]); \
      _Pragma("unroll") for(int r=4;r<16;r+=4){a=MX3(a,C0[r],C0[r+1]);b=MX3(b,C0[r+2],C0[r+3]);a=MX3(a,C1[r],C1[r+1]);b=MX3(b,C1[r+2],C1[r+3]);} \
      float rm=__builtin_fmaxf(a,b); { auto rr=__builtin_amdgcn_permlane32_swap(__float_as_uint(rm),__float_as_uint(rm),false,false); rm=__builtin_fmaxf(__uint_as_float(rr[0]),__uint_as_float(rr[1])); } \
      resc=false; \
      if(__builtin_expect(__any(rm>(float)THRL),0)){ const float dl=__builtin_fmaxf(rm,0.f); mhat+=dl; \
        _Pragma("unroll") for(int r=0;r<16;++r){C0[r]-=dl;C1[r]-=dl;} \
        _Pragma("unroll") for(int r=0;r<16;++r)negm[r]=-mhat; asm volatile("":"+v"(negm)); \
        const float f=__builtin_amdgcn_exp2f(-dl); l_reg*=f; if(hi==0)wsf[r32]=f; resc=true; } } \
    SBAR(); \
    GAPB(o[0]=__builtin_amdgcn_mfma_f32_32x32x16_bf16(PAF(0),VFR(0),o[0],0,0,0), C0,0); \
    GAPB(o[1]=__builtin_amdgcn_mfma_f32_32x32x16_bf16(PAF(0),VFR(4),o[1],0,0,0), C0,4); \
    KRD(GL,0); GAPB(o[0]=__builtin_amdgcn_mfma_f32_32x32x16_bf16(PAF(1),VFR(1),o[0],0,0,0), C0,8); \
    KRD(GL,1); GAPB(o[1]=__builtin_amdgcn_mfma_f32_32x32x16_bf16(PAF(1),VFR(5),o[1],0,0,0), C0,12); \
    KRD(GL,2); GAPB(o[0]=__builtin_amdgcn_mfma_f32_32x32x16_bf16(PAF(2),VFR(2),o[0],0,0,0), C1,0); \
    KRD(GL,3); GAPB(o[1]=__builtin_amdgcn_mfma_f32_32x32x16_bf16(PAF(2),VFR(6),o[1],0,0,0), C1,4); \
    GAPB(o[0]=__builtin_amdgcn_mfma_f32_32x32x16_bf16(PAF(3),VFR(3),o[0],0,0,0), C1,8); \
    GAPB(o[1]=__builtin_amdgcn_mfma_f32_32x32x16_bf16(PAF(3),VFR(7),o[1],0,0,0), C1,12); \
    }while(0)
  int t=1;
  for(;t+5<NT;t+=2){
    STEP(pB0,pB1,pA0,pA1,t,true,true,true);     WAIT_BAR(2); RESC(); ROT();
    STEP(pA0,pA1,pB0,pB1,t+1,true,true,true);   WAIT_BAR(2); RESC(); ROT();
  }
  #define ENDW(tt) do{ if((tt)+3<NT){WAIT_BAR(2);} else if((tt)+2<NT){WAIT_BAR(1);} else {WAIT_BAR(0);} }while(0)
  for(;t+1<NT;t+=2){
    STEP(pB0,pB1,pA0,pA1,t,(t+3<NT),(t+1<NT),(t+1<NT));       ENDW(t);   RESC(); ROT();
    STEP(pA0,pA1,pB0,pB1,t+1,(t+4<NT),(t+2<NT),(t+2<NT));     ENDW(t+1); RESC(); ROT();
  }
  STEP(pB0,pB1,pA0,pA1,NT-1,false,false,false); RESC();
  { float sacc=pB0[0]+pB0[1]; _Pragma("unroll") for(int r=2;r<16;++r)sacc+=pB0[r]; _Pragma("unroll") for(int r=0;r<16;++r)sacc+=pB1[r]; l_reg+=sacc;
    pw0=(u32x4){PKW(pB0,0),PKW(pB0,2),PKW(pB0,4),PKW(pB0,6)};pw1=(u32x4){PKW(pB0,8),PKW(pB0,10),PKW(pB0,12),PKW(pB0,14)};pw2=(u32x4){PKW(pB1,0),PKW(pB1,2),PKW(pB1,4),PKW(pB1,6)};pw3=(u32x4){PKW(pB1,8),PKW(pB1,10),PKW(pB1,12),PKW(pB1,14)};
    SBAR(); pv(o,vb0+sl_cur,PAF(0),PAF(1),PAF(2),PAF(3)); }
  #undef PKW
  #undef PAF
  #undef VFR
  #undef PIN
  #undef MX3
  #undef GAPA
  #undef GAPB
  #undef EX
  #undef VRD
  #undef KRD
  #undef STEP
  #undef ENDW
  {auto rr=__builtin_amdgcn_permlane32_swap(__float_as_uint(l_reg),__float_as_uint(l_reg),false,false);l_reg=__uint_as_float(rr[0])+__uint_as_float(rr[1]);}
  if(hi==0)wsf[32+r32]=l_reg;asm volatile("s_waitcnt lgkmcnt(0)":::"memory");
  float rli[16];
  #pragma unroll
  for(int r=0;r<16;++r)rli[r]=__builtin_amdgcn_rcpf(wsf[32+crow(r,hi)]);
  bf16*Ow=O+(rowbase+q0+wid*QBLK)*OP+h*D;
  { bf16*stg=(bf16*)(shm+LDS_OST)+wid*2048;
    #pragma unroll
    for(int r=0;r<16;++r){const int orow=crow(r,hi);
      #pragma unroll
      for(int d0=0;d0<2;++d0)stg[orow*64+d0*32+r32]=__float2bfloat16(o[d0][r]*rli[r]);}
    asm volatile("s_waitcnt lgkmcnt(0)":::"memory");
    #pragma unroll
    for(int i=0;i<4;++i){const int row=i*8+(lane>>3),ch=lane&7; const u32x4 v=*(const u32x4*)(stg+row*64+ch*8); ATTN_STORE16(Ow+(long)row*OP+ch*8,v);} }
  asm volatile("s_waitcnt lgkmcnt(0)\n\ts_barrier":::"memory");
  #undef DMA_K
  #undef DMA_V
  #undef CMASK
  #undef START
  #undef RESC
  #undef ROT
}
constexpr int ATTN_LDS_BYTES=LDS_BYTES;
#undef SBAR
#undef WAIT_BAR
}
typedef unsigned short us16;
#define GAS __attribute__((address_space(1)))
template <int CTRL> __device__ __forceinline__ int dpp_i(int v) { return __builtin_amdgcn_update_dpp(0, v, CTRL, 0xf, 0xf, true); }
template <int CTRL> __device__ __forceinline__ float dpp_f(float v) { return __builtin_bit_cast(float, __builtin_amdgcn_update_dpp(0, __builtin_bit_cast(int, v), CTRL, 0xf, 0xf, true)); }
__device__ __forceinline__ int row16_sum_i(int x) { x += dpp_i<0xB1>(x); x += dpp_i<0x4E>(x); x += dpp_i<0x141>(x); x += dpp_i<0x140>(x); return x; }
__device__ __forceinline__ float row16_sum_f(float x) { x += dpp_f<0xB1>(x); x += dpp_f<0x4E>(x); x += dpp_f<0x141>(x); x += dpp_f<0x140>(x); return x; }
__device__ __forceinline__ unsigned half32_sum_u(unsigned x) { int y = row16_sum_i((int)x); y += __shfl_xor(y, 16); return (unsigned)y; }
__device__ __forceinline__ unsigned half32_max_u(unsigned x) {
#pragma unroll
    for (int o = 1; o < 32; o <<= 1) { const unsigned y = (unsigned)__shfl_xor((int)x, o); x = x > y ? x : y; }
    return x; }
__device__ __forceinline__ unsigned half32_min_u(unsigned x) {
#pragma unroll
    for (int o = 1; o < 32; o <<= 1) { const unsigned y = (unsigned)__shfl_xor((int)x, o); x = x < y ? x : y; }
    return x; }
__device__ __forceinline__ int crow(int r, int hi) { return (r & 3) + 8 * (r >> 2) + 4 * hi; }
__device__ __forceinline__ constexpr int sig(int p) { return 16 * ((p & 7) >> 2) + 4 * (p >> 3) + (p & 3); }
__device__ __forceinline__ constexpr int sig_inv(int x) { return 8 * ((x >> 2) & 3) + 4 * (x >> 4) + (x & 3); }
__device__ __forceinline__ unsigned pkbf(float lo, float hi) { return pg8::cvt_pk_bf16(lo, hi); }

__device__ __forceinline__ void indexer_unit(const Args& A, LAS unsigned char* lds, int b, int qb, int wave, int lane) {
    const unsigned char* ws = A.ws;
    const bf16* QI = (const bf16*)(ws + WS_QI); const bf16* KI = (const bf16*)(ws + WS_KI); const float* SM = (const float*)(ws + WS_SM);
    unsigned* MASK = (unsigned*)(ws + WS_MASK);
    const int r = lane & 31, hi = lane >> 5; const int t0 = qb * 32; const size_t tb = (size_t)b * SEQ;
    const int jn = qb + 1;
    bf16x8 af[4];
    { const int a = r >> 3, hq = (r >> 2) & 1, i = r & 3; const int qq = 2 * hq + (a >> 1), head = 4 * (a & 1) + i;
      const bf16* p = QI + (tb + t0 + 4 * wave + qq) * 512 + head * 64 + 8 * hi;
#pragma unroll
      for (int s = 0; s < 4; ++s) af[s] = *(const bf16x8*)(p + 16 * s); }
    float wq[2][8];
#pragma unroll
    for (int q2 = 0; q2 < 2; ++q2) { const float* p = SM + (tb + t0 + 4 * wave + 2 * hi + q2) * 16; const f32x4 w0 = *(const f32x4*)p, w1 = *(const f32x4*)(p + 4);
        wq[q2][0] = w0[0]; wq[q2][1] = w0[1]; wq[q2][2] = w0[2]; wq[q2][3] = w0[3]; wq[q2][4] = w1[0]; wq[q2][5] = w1[1]; wq[q2][6] = w1[2]; wq[q2][7] = w1[3]; }
    unsigned key[2][64];
    const int qloc0 = 4 * wave + 2 * hi;
    const GAS bf16* kp = (const GAS bf16*)(KI + (tb + r) * 64 + 8 * hi);
    bf16x8 cur[4], nxt[4];
#pragma unroll
    for (int s = 0; s < 4; ++s) { cur[s] = *(const GAS bf16x8*)(kp + 16 * s); nxt[s] = cur[s]; }
    int jn1 = jn; asm volatile("" : "+s"(jn1));
#pragma unroll
    for (int j = 0; j < 64; ++j) {
        if (j < jn1) {
            kp += 32 * 64; asm volatile("" : "+v"(kp));
            if (j + 1 < jn1) {
#pragma unroll
                for (int s = 0; s < 4; ++s) nxt[s] = *(const GAS bf16x8*)(kp + 16 * s);
            }
            f32x16 c = {};
#pragma unroll
            for (int s = 0; s < 4; ++s) c = __builtin_amdgcn_mfma_f32_32x32x16_bf16(af[s], cur[s], c, 0, 0, 0);
#pragma unroll
            for (int q2 = 0; q2 < 2; ++q2) { float s = 0.f;
#pragma unroll
                for (int hh = 0; hh < 8; ++hh) s += wq[q2][hh] * __builtin_fmaxf(c[8 * q2 + hh], 0.f);
                s += 0.0f;
                const unsigned u = __builtin_bit_cast(unsigned, s); unsigned k = (u >> 31) ? ~u : (u | 0x80000000u);
                if (j == jn1 - 1 && r > qloc0 + q2) k = 0u;
                key[q2][j] = k; }
#pragma unroll
            for (int s = 0; s < 4; ++s) cur[s] = nxt[s];
            __builtin_amdgcn_sched_barrier(0);
        } else { key[0][j] = 0u; key[1][j] = 0u; }
    }
    unsigned lo[2], hv[2], ksel[2];
#pragma unroll
    for (int q2 = 0; q2 < 2; ++q2) { unsigned mx = 0u, mn = 0xffffffffu;
#pragma unroll
        for (int j = 0; j < 64; ++j) { const unsigned k = key[q2][j]; mx = k > mx ? k : mx; const unsigned k1 = k - 1u; mn = k1 < mn ? k1 : mn; }
        hv[q2] = half32_max_u(mx); lo[q2] = half32_min_u(mn) + 1u; const int tq = t0 + qloc0 + q2; ksel[q2] = (unsigned)(tq + 1 < 256 ? tq + 1 : 256); if (tq + 1 <= 256) hv[q2] = lo[q2]; }
    int jn2 = jn; asm volatile("" : "+s"(jn2));
    while (__any((lo[0] < hv[0]) || (lo[1] < hv[1]))) {
        unsigned mid[2]; mid[0] = lo[0] + ((hv[0] - lo[0] + 1u) >> 1); mid[1] = lo[1] + ((hv[1] - lo[1] + 1u) >> 1);
        unsigned c0 = 0u, c1 = 0u;
#pragma unroll
        for (int jc = 0; jc < 8; ++jc) { if (8 * jc < jn2) {
#pragma unroll
            for (int j = 8 * jc; j < 8 * jc + 8; ++j) { c0 += (key[0][j] >= mid[0]) ? 1u : 0u; c1 += (key[1][j] >= mid[1]) ? 1u : 0u; } } }
        const unsigned tot = half32_sum_u(c0 | (c1 << 16));
        const unsigned t0c = tot & 0xffffu, t1c = tot >> 16;
        if (lo[0] < hv[0]) { if (t0c >= ksel[0]) lo[0] = mid[0]; else hv[0] = mid[0] - 1u; if (t0c == ksel[0]) hv[0] = mid[0]; }
        if (lo[1] < hv[1]) { if (t1c >= ksel[1]) lo[1] = mid[1]; else hv[1] = mid[1] - 1u; if (t1c == ksel[1]) hv[1] = mid[1]; }
    }
    unsigned need[2];
    { unsigned c0 = 0u, c1 = 0u;
#pragma unroll
      for (int j = 0; j < 64; ++j) { c0 += (key[0][j] > lo[0]) ? 1u : 0u; c1 += (key[1][j] > lo[1]) ? 1u : 0u; }
      const unsigned tot = half32_sum_u(c0 | (c1 << 16)); need[0] = ksel[0] - (tot & 0xffffu); need[1] = ksel[1] - (tot >> 16); }
    unsigned run[2] = {0u, 0u};
    const unsigned ltmask = (1u << r) - 1u;
    int jn3 = jn; asm volatile("" : "+s"(jn3));
    { unsigned lb = (unsigned)(uintptr_t)lds; asm volatile("" : "+v"(lb)); lds = (LAS unsigned char*)(uintptr_t)lb; }
    LAS unsigned* lm = (LAS unsigned*)lds + (wave * 4 + 2 * hi) * 64;
    lm[r] = 0u; lm[32 + r] = 0u; lm[64 + r] = 0u; lm[96 + r] = 0u;
#pragma unroll
    for (int j = 0; j < 64; ++j) {
        if (j < jn3) {
#pragma unroll
            for (int q2 = 0; q2 < 2; ++q2) { const unsigned k = key[q2][j]; const bool gt = k > lo[q2], eq = (k == lo[q2]);
                const unsigned long long be = __ballot(eq); const unsigned hm = hi ? (unsigned)(be >> 32) : (unsigned)be;
                const unsigned rank = run[q2] + (unsigned)__builtin_popcount(hm & ltmask); run[q2] += (unsigned)__builtin_popcount(hm);
                const bool sel = gt || (eq && rank < need[q2]);
                const unsigned long long bs = __ballot(sel); const unsigned sw = hi ? (unsigned)(bs >> 32) : (unsigned)bs;
                lm[q2 * 64 + j] = sw; }
            __builtin_amdgcn_sched_barrier(0);
        }
    }
#pragma unroll
    for (int q2 = 0; q2 < 2; ++q2) { unsigned* mp = MASK + (tb + t0 + qloc0 + q2) * 64; mp[r] = lm[q2 * 64 + r]; mp[32 + r] = lm[q2 * 64 + 32 + r]; }
    LDS_WAIT();
}
__device__ __forceinline__ void p6_indexer(const Args& A, LAS unsigned char* lds, int tid, int wave, int lane, int bid, int G) {
    for (int u = bid, it = 0; u < BATCH * 64; u += G, ++it) {
        int b, qb;
        if (G == 256) { b = bid >> 4; const int rr = bid & 15; qb = (it == 0) ? rr : (it == 1) ? 31 - rr : (it == 2) ? 32 + rr : 63 - rr; }
        else { b = u >> 6; qb = u & 63; }
        indexer_unit(A, lds, b, qb, wave, lane);
    }
}

constexpr int DN_L = 0, DN_KB = 65536, DN_QB = 82944, DN_SC = 100352;
__device__ __forceinline__ void dn_prep_unit(const Args& A, LAS unsigned char* lds, int b, int n, int h, int tid, int wave, int lane) {
    unsigned char* ws = A.ws;
    const bf16* B4 = (const bf16*)(ws + WS_B4); const float* SM = (const float*)(ws + WS_SM);
    bf16* NEGW = (bf16*)A.out; bf16* QD = NEGW + (size_t)T * 512; bf16* KDT = QD + (size_t)T * 512; bf16* UB = KDT + (size_t)T * 512;
    bf16* AQK = (bf16*)(ws + WS_AQK); float* GL = (float*)(ws + WS_GL);
    const int cu = (b * 32 + n) * 4 + h; const size_t tokb = (size_t)b * SEQ + 64 * n;
    { unsigned lb = (unsigned)(uintptr_t)lds; asm volatile("" : "+v"(lb)); lds = (LAS unsigned char*)(uintptr_t)lb; }
    LAS float* sq = (LAS float*)(lds + DN_L);
    LAS float* Lm = (LAS float*)(lds + DN_L);
    LAS us16* kb = (LAS us16*)(lds + DN_KB); LAS us16* qbuf = (LAS us16*)(lds + DN_QB);
    LAS float* s_la = (LAS float*)(lds + DN_SC);
    LAS float* s_beta = s_la + 64; LAS float* s_eg = s_la + 128; LAS float* s_ekd = s_la + 192; LAS float* s_rn = s_la + 256;
    float val[64];
    const int grp = tid >> 7, c = tid & 127;
    if (grp < 3) {
        const int col = grp * 512 + h * 128 + c;
        const float cw0 = A.conv_w[0 * 1536 + col], cw1 = A.conv_w[1 * 1536 + col], cw2 = A.conv_w[2 * 1536 + col], cw3 = A.conv_w[3 * 1536 + col];
        const bf16* src = B4 + tokb * 2048 + col;
        unsigned short xin[67];
        { const GAS bf16* sp = (const GAS bf16*)src - 3 * 2048;
          if (n > 0) { xin[0] = sp[0]; xin[1] = sp[2048]; xin[2] = sp[4096]; } else { xin[0] = 0; xin[1] = 0; xin[2] = 0; }
          sp += 3 * 2048;
#pragma unroll
          for (int i = 0; i < 64; ++i) { xin[3 + i] = *sp; sp += 2048; asm volatile("" : "+v"(sp)); } }
#pragma unroll
        for (int i = 0; i < 64; ++i) { const float y = cw0 * bf2f(xin[i]) + cw1 * bf2f(xin[i + 1]) + cw2 * bf2f(xin[i + 2]) + cw3 * bf2f(xin[i + 3]); val[i] = pg8::silu_f(y); }
        if (grp < 2) {
#pragma unroll
            for (int i = 0; i < 64; ++i) sq[(grp * 64 + i) * 128 + c] = val[i] * val[i];
        }
    } else {
#pragma unroll
        for (int i = 0; i < 64; ++i) val[i] = 0.f;
        if (c < 64) { const float* sm = SM + (tokb + c) * 16; const float ba = sm[8 + h], bb = sm[12 + h];
            const float z = ba + A.dt_bias[h]; const float sp = (z > 20.f) ? z : log1pf(__expf(z));
            s_la[c] = -__expf(A.a_log[h]) * sp; s_beta[c] = 1.0f / (1.0f + __expf(-bb)); }
    }
    __syncthreads();
    { const int row = tid >> 2, part = tid & 3; const LAS float* p = sq + row * 128 + 32 * part; float s = 0.f;
#pragma unroll
      for (int i = 0; i < 32; ++i) s += p[i];
      s += __shfl_xor(s, 1); s += __shfl_xor(s, 2);
      if (part == 0) s_rn[row] = 1.0f / sqrtf(s + RMS_EPS); }
    if (wave == 7) {
        float g = s_la[lane];
#pragma unroll
        for (int o = 1; o < 64; o <<= 1) { const float t = __shfl_up(g, o); if (lane >= o) g += t; }
        const float g63 = __shfl(g, 63);
        s_la[lane] = g; s_eg[lane] = __expf(g); s_ekd[lane] = __expf(g63 - g);
        if (lane == 0) GL[cu] = __expf(g63);
    }
    __syncthreads();
    if (grp == 0) {
#pragma unroll
        for (int i = 0; i < 64; ++i) { val[i] *= s_rn[i] * 0.08838834764831845f; qbuf[i * 136 + c] = (us16)f2bf(val[i]); }
        bf16* qd = QD + tokb * 512 + h * 128 + 32 * (c >> 5) + sig_inv(c & 31);
#pragma unroll
        for (int i = 0; i < 64; ++i) { *qd = (bf16)f2bf(val[i] * s_eg[i]); qd += 512; asm volatile("" : "+v"(qd)); }
    } else if (grp == 1) {
#pragma unroll
        for (int i = 0; i < 64; ++i) { val[i] *= s_rn[64 + i]; kb[i * 136 + c] = (us16)f2bf(val[i]); }
        bf16* kd = KDT + ((size_t)cu * 128 + c) * 64;
#pragma unroll
        for (int p8 = 0; p8 < 8; ++p8) { v4u o;
#define KDV(pp) (val[32 * ((8 * p8 + (pp)) >> 5) + sig((8 * p8 + (pp)) & 31)] * s_ekd[32 * ((8 * p8 + (pp)) >> 5) + sig((8 * p8 + (pp)) & 31)])
            o.x = pk2(KDV(0), KDV(1)); o.y = pk2(KDV(2), KDV(3)); o.z = pk2(KDV(4), KDV(5)); o.w = pk2(KDV(6), KDV(7));
#undef KDV
            *(v4u*)(kd + 8 * p8) = o; }
    }
    __syncthreads();
    if (wave < 6) {
        const int tI = (wave % 3) >= 1 ? 1 : 0, tJ = (wave % 3) == 2 ? 1 : 0; const bool isq = wave >= 3;
        const int r = lane & 31, hi = lane >> 5;
        const LAS us16* ap = (isq ? qbuf : kb) + (32 * tI + r) * 136 + 8 * hi; const LAS us16* bp = kb + (32 * tJ + r) * 136 + 8 * hi;
        f32x16 cacc = {};
#pragma unroll
        for (int s = 0; s < 8; ++s) { const bf16x8 a = *(const LAS bf16x8*)(ap + 16 * s), bb = *(const LAS bf16x8*)(bp + 16 * s); cacc = __builtin_amdgcn_mfma_f32_32x32x16_bf16(a, bb, cacc, 0, 0, 0); }
        const int j = 32 * tJ + r; const float gj = s_la[j];
#pragma unroll
        for (int reg = 0; reg < 16; ++reg) { const int i = 32 * tI + crow(reg, hi); const float gi = s_la[i];
            if (!isq) { const bool m = j < i; const float v = m ? s_beta[i] * cacc[reg] * __expf(m ? gi - gj : 0.f) : 0.f; Lm[i * 68 + j] = v; }
            else { const bool m = j <= i; const float v = m ? cacc[reg] * __expf(m ? gi - gj : 0.f) : 0.f; AQK[(size_t)cu * 4096 + i * 64 + 32 * tJ + sig_inv(r)] = (bf16)f2bf(v); } }
    } else if (wave == 6) {
        for (int e = lane; e < 32 * 32 / 8; e += 64) { const int i = e >> 2, ch = e & 3; *(v4u*)(AQK + (size_t)cu * 4096 + i * 64 + 32 + 8 * ch) = (v4u){0u, 0u, 0u, 0u}; }
    }
    __syncthreads();
    if (grp == 1 || grp == 2) {
#pragma unroll
        for (int i = 0; i < 64; ++i) val[i] *= (grp == 1) ? s_beta[i] * s_eg[i] : s_beta[i];
#pragma unroll
        for (int i = 1; i < 64; ++i) { float a0 = 0.f, a1 = 0.f, a2 = 0.f, a3 = 0.f;
#pragma unroll
            for (int m4 = 0; m4 < (i + 3) / 4; ++m4) { const f32x4 l4 = *(const LAS f32x4*)(Lm + i * 68 + 4 * m4);
                a0 += l4[0] * val[4 * m4];
                if (4 * m4 + 1 < i) a1 += l4[1] * val[4 * m4 + 1];
                if (4 * m4 + 2 < i) a2 += l4[2] * val[4 * m4 + 2];
                if (4 * m4 + 3 < i) a3 += l4[3] * val[4 * m4 + 3]; }
            val[i] -= (a0 + a1) + (a2 + a3); }
        if (grp == 1) { bf16* wp = NEGW + tokb * 512 + h * 128 + 32 * (c >> 5) + sig_inv(c & 31);
#pragma unroll
            for (int i = 0; i < 64; ++i) { *wp = (bf16)f2bf(-val[i]); wp += 512; asm volatile("" : "+v"(wp)); }
        } else { bf16* up = UB + tokb * 512 + h * 128 + c;
#pragma unroll
            for (int i = 0; i < 64; ++i) { *up = (bf16)f2bf(val[i]); up += 512; asm volatile("" : "+v"(up)); } }
    }
    __syncthreads();
}
__device__ __forceinline__ void p6_dn_prep(const Args& A, LAS unsigned char* lds, int tid, int wave, int lane, int bid, int G) {
    for (int u = bid; u < BATCH * 32 * 4; u += G) { const int h = u & 3, n = (u >> 2) & 31, b = u >> 7; dn_prep_unit(A, lds, b, n, h, tid, wave, lane); }
}

constexpr int SC_W = 0, SC_QD = 17408, SC_AQK = 34816, SC_KDT = 44032, SC_U = 62464, SC_BUF = 66560, SC_XS = 2 * SC_BUF;
__device__ __forceinline__ void dn_scan_unit(const Args& A, LAS unsigned char* lds, int b, int h, int q4, int tid, int wave, int lane) {
    unsigned char* ws = A.ws;
    const bf16* NEGW = (const bf16*)A.out; const bf16* QD = NEGW + (size_t)T * 512; const bf16* KDT = QD + (size_t)T * 512; const bf16* UB = KDT + (size_t)T * 512;
    const bf16* AQK = (const bf16*)(ws + WS_AQK); const float* GL = (const float*)(ws + WS_GL);
    bf16* DN = (bf16*)(ws + WS_QI); float* SSQ = (float*)(ws + WS_SM);
    { unsigned lb = (unsigned)(uintptr_t)lds; asm volatile("" : "+v"(lb)); lds = (LAS unsigned char*)(uintptr_t)lb; }
    const size_t tok0 = (size_t)b * SEQ; const int cu0 = (b * 32) * 4 + h;
    if (wave >= 2) {
        const int tl = tid - 128;
        const GAS unsigned char* src[10]; unsigned dst[10], stride[10];
#pragma unroll
        for (int k = 0; k < 10; ++k) { const int p = tl + 384 * k;
            if (p < 1024) { const int row = p >> 4, c = p & 15; src[k] = (const GAS unsigned char*)(NEGW + (tok0 + row) * 512 + h * 128 + 8 * c); dst[k] = SC_W + row * 272 + 16 * c; stride[k] = 64 * 512 * 2; }
            else if (p < 2048) { const int pp = p - 1024, row = pp >> 4, c = pp & 15; src[k] = (const GAS unsigned char*)(QD + (tok0 + row) * 512 + h * 128 + 8 * c); dst[k] = SC_QD + row * 272 + 16 * c; stride[k] = 64 * 512 * 2; }
            else if (p < 2560) { const int pp = p - 2048, row = pp >> 3, c = pp & 7; src[k] = (const GAS unsigned char*)(AQK + (size_t)cu0 * 4096 + row * 64 + 8 * c); dst[k] = SC_AQK + row * 144 + 16 * c; stride[k] = 4 * 4096 * 2; }
            else if (p < 3584) { const int pp = p - 2560, row = pp >> 3, c = pp & 7; src[k] = (const GAS unsigned char*)(KDT + ((size_t)cu0 * 128 + row) * 64 + 8 * c); dst[k] = SC_KDT + row * 144 + 16 * c; stride[k] = 4 * 128 * 64 * 2; }
            else { const int pp = p - 3584, row = pp >> 2, c = pp & 3; src[k] = (const GAS unsigned char*)(UB + (tok0 + row) * 512 + h * 128 + 32 * q4 + 8 * c); dst[k] = SC_U + row * 64 + 16 * c; stride[k] = 64 * 512 * 2; } }
        for (int n = 0; n <= 32; ++n) {
            if (n < 32) { v4u v[10];
#pragma unroll
                for (int k = 0; k < 10; ++k) { v[k] = *(const GAS v4u*)src[k]; src[k] += stride[k]; }
                LAS unsigned char* bufp = lds + (n & 1) * SC_BUF;
#pragma unroll
                for (int k = 0; k < 10; ++k) *(LAS v4u*)(bufp + dst[k]) = v[k]; }
            __syncthreads();
        }
    } else {
        const int fr = lane & 15, g = lane >> 4, cw = wave; const int dvl = 16 * cw + fr;
        f32x4 S[8];
#pragma unroll
        for (int a = 0; a < 8; ++a) S[a] = (f32x4){0.f, 0.f, 0.f, 0.f};
        LAS float* xs = (LAS float*)(lds + SC_XS);
        float mys[16];
#pragma unroll
        for (int i = 0; i < 16; ++i) mys[i] = 0.f;
        __syncthreads();
        for (int n = 0; n < 32; ++n) {
            const LAS unsigned char* bufp = lds + (n & 1) * SC_BUF;
            const int cu = cu0 + 4 * n; const size_t tokb = tok0 + 64 * n;
            const float gl = GL[cu];
            if (n > 0 && cw == 0) {
                const LAS float* xp = xs + ((n - 1) & 1) * 64;
#pragma unroll
                for (int m = 0; m < 4; ++m)
#pragma unroll
                    for (int rho = 0; rho < 4; ++rho) { const int tk = 16 * m + 4 * g + rho; const float q = mys[4 * m + rho] + xp[tk]; if (fr == 0) SSQ[(tokb - 64 + tk) * 16 + h * 4 + q4] = q; }
            }
            bf16x8 Bs[4];
#pragma unroll
            for (int s = 0; s < 4; ++s) { v4u w; w.x = pkbf(S[2 * s][0], S[2 * s][1]); w.y = pkbf(S[2 * s][2], S[2 * s][3]); w.z = pkbf(S[2 * s + 1][0], S[2 * s + 1][1]); w.w = pkbf(S[2 * s + 1][2], S[2 * s + 1][3]); Bs[s] = __builtin_bit_cast(bf16x8, w); }
            f32x4 dl[4], ot[4];
#pragma unroll
            for (int m = 0; m < 4; ++m) {
                const LAS us16* up = (const LAS us16*)(bufp + SC_U + (16 * m + 4 * g) * 64) + dvl;
                f32x4 d = (f32x4){bf2f(up[0]), bf2f(up[32]), bf2f(up[64]), bf2f(up[96])};
                f32x4 o = (f32x4){0.f, 0.f, 0.f, 0.f};
                const LAS unsigned char* wp = bufp + SC_W + (16 * m + fr) * 272 + 16 * g; const LAS unsigned char* qp = bufp + SC_QD + (16 * m + fr) * 272 + 16 * g;
#pragma unroll
                for (int s = 0; s < 4; ++s) { const bf16x8 wa = *(const LAS bf16x8*)(wp + 64 * s), qa = *(const LAS bf16x8*)(qp + 64 * s);
                    d = __builtin_amdgcn_mfma_f32_16x16x32_bf16(wa, Bs[s], d, 0, 0, 0); o = __builtin_amdgcn_mfma_f32_16x16x32_bf16(qa, Bs[s], o, 0, 0, 0); }
                dl[m] = d; ot[m] = o;
            }
            bf16x8 Bd[2];
#pragma unroll
            for (int s2 = 0; s2 < 2; ++s2) { v4u w; w.x = pkbf(dl[2 * s2][0], dl[2 * s2][1]); w.y = pkbf(dl[2 * s2][2], dl[2 * s2][3]); w.z = pkbf(dl[2 * s2 + 1][0], dl[2 * s2 + 1][1]); w.w = pkbf(dl[2 * s2 + 1][2], dl[2 * s2 + 1][3]); Bd[s2] = __builtin_bit_cast(bf16x8, w); }
#pragma unroll
            for (int m = 0; m < 4; ++m) { const LAS unsigned char* ap = bufp + SC_AQK + (16 * m + fr) * 144 + 16 * g;
#pragma unroll
                for (int s2 = 0; s2 < 2; ++s2) { const bf16x8 aa = *(const LAS bf16x8*)(ap + 64 * s2); ot[m] = __builtin_amdgcn_mfma_f32_16x16x32_bf16(aa, Bd[s2], ot[m], 0, 0, 0); } }
#pragma unroll
            for (int a = 0; a < 8; ++a) { const LAS unsigned char* kp = bufp + SC_KDT + (16 * a + fr) * 144 + 16 * g; f32x4 sn = S[a] * gl;
#pragma unroll
                for (int s2 = 0; s2 < 2; ++s2) { const bf16x8 ka = *(const LAS bf16x8*)(kp + 64 * s2); sn = __builtin_amdgcn_mfma_f32_16x16x32_bf16(ka, Bd[s2], sn, 0, 0, 0); }
                S[a] = sn; }
            bf16* dnp = DN + (tokb + 4 * g) * 512 + h * 128 + 32 * q4 + dvl;
#pragma unroll
            for (int m = 0; m < 4; ++m)
#pragma unroll
                for (int rho = 0; rho < 4; ++rho) { const float v = ot[m][rho]; dnp[(size_t)(16 * m + rho) * 512] = (bf16)f2bf(v); const float vb = bf2f((unsigned short)f2bf(v)); mys[4 * m + rho] = row16_sum_f(vb * vb); }
            if (cw == 1 && fr == 0) { LAS float* xp = xs + (n & 1) * 64;
#pragma unroll
                for (int m = 0; m < 4; ++m)
#pragma unroll
                    for (int rho = 0; rho < 4; ++rho) xp[16 * m + 4 * g + rho] = mys[4 * m + rho]; }
            __syncthreads();
        }
        if (cw == 0) { const LAS float* xp = xs + 64; const size_t tokb = tok0 + 64 * 31;
#pragma unroll
            for (int m = 0; m < 4; ++m)
#pragma unroll
                for (int rho = 0; rho < 4; ++rho) { const int tk = 16 * m + 4 * g + rho; const float q = mys[4 * m + rho] + xp[tk]; if (fr == 0) SSQ[(tokb + tk) * 16 + h * 4 + q4] = q; } }
    }
    __syncthreads();
}
__device__ __forceinline__ void p7c_dn_finalize(const Args& A, int wave, int lane, int bid, int G) {
    const unsigned char* ws = A.ws;
    const bf16* DN = (const bf16*)(ws + WS_QI); const float* SSQ = (const float*)(ws + WS_SM); const bf16* B4 = (const bf16*)(ws + WS_B4); bf16* MIX = (bf16*)(A.ws + WS_U);
    const int gw = bid * NWAVES + wave, NGW = G * NWAVES; const int hd = lane >> 4;
    const f32x4 g0 = *(const f32x4*)(A.dn_g + 8 * (lane & 15)), g1 = *(const f32x4*)(A.dn_g + 8 * (lane & 15) + 4);
    for (int t = gw; t < T; t += NGW) {
        const f32x4 sq = *(const f32x4*)(SSQ + (size_t)t * 16 + 4 * hd);
        const float rinv = 1.0f / sqrtf(((sq[0] + sq[1]) + (sq[2] + sq[3])) * (1.0f / 128.0f) + RMS_EPS);
        const v4u dv = *(const v4u*)(DN + (size_t)t * 512 + 8 * lane), zv = *(const v4u*)(B4 + (size_t)t * 2048 + 1536 + 8 * lane);
        v4u o;
#define FIN(w, ga, gb) pk2(bf2f((unsigned short)(dv.w & 0xffffu)) * rinv * (ga) * pg8::silu_f(bf2f((unsigned short)(zv.w & 0xffffu))), bf2f((unsigned short)(dv.w >> 16)) * rinv * (gb) * pg8::silu_f(bf2f((unsigned short)(zv.w >> 16))))
        o.x = FIN(x, g0[0], g0[1]); o.y = FIN(y, g0[2], g0[3]); o.z = FIN(z, g1[0], g1[1]); o.w = FIN(w, g1[2], g1[3]);
#undef FIN
        *(v4u*)(MIX + (size_t)t * 1024 + 512 + 8 * lane) = o;
    }
}
__device__ __forceinline__ void p7_mixer(const Args& A, LAS unsigned char* lds, int tid, int wave, int lane, int bid, int G, int mode) {
    if (mode != 4) for (int u = bid; u < 256; u += G) { const int q4 = (u >> 3) & 3, bh = (u & 7) + 8 * (u >> 5); dn_scan_unit(A, lds, bh >> 2, bh & 3, q4, tid, wave, lane); }
    if (mode == 3) return;
    unsigned* ctr = (unsigned*)(A.ws + WS_CTL) + CW_QUEUE * (mode == 4 ? 2 : mode);
    LAS unsigned* slot = (LAS unsigned*)(lds + 2048);
    for (;;) {
        if (tid == 0) slot[0] = atomicAdd(ctr, 1u);
        __syncthreads();
        const unsigned u = slot[0];
        __syncthreads();
        if (u >= (unsigned)(BATCH * 8 * 8)) break;
        const int qb = 7 - (int)(u >> 7), bh = (int)(u & 127);
        attn_body::attn_unit<8>(bh >> 3, bh & 7, qb, (const attn_body::bf16*)(A.ws + WS_Q), (const attn_body::bf16*)(A.ws + WS_K), (const attn_body::bf16*)(A.ws + WS_VT),
                                (attn_body::bf16*)(A.ws + WS_U), (const unsigned*)(A.ws + WS_MASK), (char*)lds);
    }
}
constexpr int LDS_BYTES = 147456;
#ifndef MIXER
#define MIXER 1
#endif

#ifndef DUP
#define DUP 0
#endif
#ifndef BARSEL
#define BARSEL 0
#endif
#define SEAM(k) do { if ((BARSEL >> (k)) & 1) grid.sync(); else xcd_barrier(bar); } while (0)
__global__ void __launch_bounds__(NTHREADS, 2) fwd_megakernel(Args A) {
    extern __shared__ __attribute__((aligned(16))) unsigned char lds_raw[];
    cg::grid_group grid = cg::this_grid();
    LAS unsigned char* lds = (LAS unsigned char*)lds_raw;
    const int tid = threadIdx.x, lane = tid & 63, wave = __builtin_amdgcn_readfirstlane(tid >> 6);
    const int bid = blockIdx.x, G = gridDim.x;
    unsigned char* ws = A.ws;
    float* mod = (float*)(ws + WS_MOD);
    bf16* U = (bf16*)(ws + WS_U); bf16* H = (bf16*)(ws + WS_H); float* X = (float*)(ws + WS_X); float* Y = A.out;
    bf16* MIX = U;
    XcdBarrier bar{(unsigned*)(ws + WS_CTL) + 4096, 0u, (unsigned)G};

    if (bid == 0 && tid < 64) __hip_atomic_store((unsigned*)(ws + WS_CTL) + (tid == 0 ? 4096 : 64 * tid), 0u, __ATOMIC_RELAXED, __HIP_MEMORY_SCOPE_AGENT);
    p0_mod(A, lds, tid, wave, lane, bid, G);
    p0_weights(A, lds, wave, lane, bid, G);
    p0_rope(A, tid, bid, G);
    grid.sync();
    p_modulate_rows(A.x, U, mod, 0 * D, 1 * D, wave, lane, bid, G);
    SEAM(1);
    { pg8::Gemm g{U, (const bf16*)(ws + WS_W13A), T, 2 * FF, D}; pg8::StaticOrder S; S.init(T, 2 * FF, G, bid);
      pg8::EpiSwiGLU E{H, FF}; pg8::gemm_phase<pg8::EpiSwiGLU, pg8::StaticOrder, true, true>(lds, g, S, E);
#if DUP == 2
      grid.sync(); pg8::gemm_phase<pg8::EpiSwiGLU, pg8::StaticOrder, true, true>(lds, g, S, E);
#endif
    }
    SEAM(2);
    { pg8::Gemm g{H, (const bf16*)(ws + WS_W2A), T, D, FF}; pg8::StaticOrder S; S.init(T, D, G, bid);
      pg8::EpiResid E{A.x, Y, mod + 2 * D, NMOD, 0.5f, ALPHA}; pg8::gemm_phase<pg8::EpiResid, pg8::StaticOrder, true, true>(lds, g, S, E);
#if DUP == 3
      grid.sync(); pg8::gemm_phase<pg8::EpiResid, pg8::StaticOrder, true, true>(lds, g, S, E);
#endif
    }
    SEAM(3);
    p_ln_rows(Y, X, U, A.ln1g, A.ln1b, mod, 3 * D, 4 * D, wave, lane, bid, G);
#if DUP == 4
    grid.sync(); p_ln_rows(Y, X, U, A.ln1g, A.ln1b, mod, 3 * D, 4 * D, wave, lane, bid, G);
#endif
    SEAM(4);
#if MIXER
    { pg8::Gemm g{U, (const bf16*)(ws + WS_WIN), T, NINP, D}; pg8::StaticOrder S; S.init(T, NINP, G, bid);
      pg8::EpiInProj E{(bf16*)(ws + WS_Q), (bf16*)(ws + WS_QI), (bf16*)(ws + WS_K), (bf16*)(ws + WS_KI), (bf16*)(ws + WS_VT), (bf16*)(ws + WS_B4), (float*)(ws + WS_SM),
                       (const float*)(ws + WS_COS), (const float*)(ws + WS_SIN), QSCALE, 0.04419417382415922f};
      pg8::gemm_phase<pg8::EpiInProj, pg8::StaticOrder, true, true>(lds, g, S, E);
#if DUP == 5
      grid.sync(); pg8::gemm_phase<pg8::EpiInProj, pg8::StaticOrder, true, true>(lds, g, S, E);
#endif
    }
    SEAM(5);
    p6_indexer(A, lds, tid, wave, lane, bid, G);
    __syncthreads();
#if DUP == 61
    grid.sync(); p6_indexer(A, lds, tid, wave, lane, bid, G); __syncthreads();
#endif
    p6_dn_prep(A, lds, tid, wave, lane, bid, G);
#if DUP == 62
    grid.sync(); p6_dn_prep(A, lds, tid, wave, lane, bid, G);
#endif
    SEAM(6);
    p7_mixer(A, lds, tid, wave, lane, bid, G, 1);
#if DUP == 7
    grid.sync(); p7_mixer(A, lds, tid, wave, lane, bid, G, 2);
#endif
#if DUP == 71
    grid.sync(); p7_mixer(A, lds, tid, wave, lane, bid, G, 3);
#endif
#if DUP == 72
    grid.sync(); p7_mixer(A, lds, tid, wave, lane, bid, G, 4);
#endif
    SEAM(7);
    p7c_dn_finalize(A, wave, lane, bid, G);
    SEAM(13);
#else
    for (size_t i = (size_t)bid * NTHREADS + tid; i < (size_t)T * D / 8; i += (size_t)G * NTHREADS) ((v4u*)MIX)[i] = (v4u){0u, 0u, 0u, 0u};
    SEAM(8);
#endif
    { pg8::Gemm g{MIX, (const bf16*)(ws + WS_WOUT), T, D, D}; pg8::StaticOrder S; S.init(T, D, G, bid);
      pg8::EpiResid E{X, Y, mod + 5 * D, NMOD, 1.0f, ALPHA}; pg8::gemm_phase<pg8::EpiResid, pg8::StaticOrder, true, true>(lds, g, S, E); }
    SEAM(9);
    p_ln_rows(Y, X, U, A.ln2g, A.ln2b, mod, 6 * D, 7 * D, wave, lane, bid, G);
    SEAM(10);
    { pg8::Gemm g{U, (const bf16*)(ws + WS_W13B), T, 2 * FF, D}; pg8::StaticOrder S; S.init(T, 2 * FF, G, bid);
      pg8::EpiSwiGLU E{H, FF}; pg8::gemm_phase<pg8::EpiSwiGLU, pg8::StaticOrder, true, true>(lds, g, S, E); }
    SEAM(11);
    { pg8::Gemm g{H, (const bf16*)(ws + WS_W2B), T, D, FF}; pg8::StaticOrder S; S.init(T, D, G, bid);
      pg8::EpiResid E{X, Y, mod + 8 * D, NMOD, 0.5f, ALPHA}; pg8::gemm_phase<pg8::EpiResid, pg8::StaticOrder, true, true>(lds, g, S, E); }
    SEAM(12);
    p_ln_rows(Y, Y, nullptr, A.ln3g, A.ln3b, mod, 0, 0, wave, lane, bid, G);
}

extern "C" void kernel_launch(void* const* d_in, const int* in_sizes, int n_in, void* d_out, int out_size, void* d_ws, size_t ws_size, hipStream_t stream) {
    static int grid_blocks = 0;
    if (grid_blocks == 0) {
        if (n_in != 23 || out_size != T * D || ws_size < WS_END) { fprintf(stderr, "kernel_launch: unexpected shapes (n_in %d out %d ws %zu)\n", n_in, out_size, ws_size); grid_blocks = -1; return; }
        int dev = 0, cus = 0, per_cu = 0;
        (void)hipGetDevice(&dev); (void)hipDeviceGetAttribute(&cus, hipDeviceAttributeMultiprocessorCount, dev);
        if (hipFuncSetAttribute((const void*)fwd_megakernel, hipFuncAttributeMaxDynamicSharedMemorySize, LDS_BYTES) != hipSuccess) { fprintf(stderr, "kernel_launch: hipFuncSetAttribute failed\n"); grid_blocks = -1; return; }
        if (hipOccupancyMaxActiveBlocksPerMultiprocessor(&per_cu, (const void*)fwd_megakernel, NTHREADS, LDS_BYTES) != hipSuccess || per_cu < 1) { fprintf(stderr, "kernel_launch: occupancy query says %d\n", per_cu); per_cu = 1; }
        (void)hipGetLastError();
        grid_blocks = cus * 1;
        fprintf(stderr, "kernel_launch: cus %d per_cu %d grid %d\n", cus, per_cu, grid_blocks);
    }
    if (grid_blocks < 0) return;
    (void)hipMemsetAsync((char*)d_ws + WS_CTL, 0, CTL_ZERO_BYTES, stream);
    Args a{};
    const float** fp = (const float**)&a;
    a.x = (const float*)d_in[0]; a.c = (const float*)d_in[1]; a.pos = (const int*)d_in[2]; a.w_ada = (const float*)d_in[3]; a.b_ada = (const float*)d_in[4];
    a.f1w1 = (const float*)d_in[5]; a.f1w3 = (const float*)d_in[6]; a.f1w2 = (const float*)d_in[7]; a.ln1g = (const float*)d_in[8]; a.ln1b = (const float*)d_in[9];
    a.w_in = (const float*)d_in[10]; a.conv_w = (const float*)d_in[11]; a.a_log = (const float*)d_in[12]; a.dt_bias = (const float*)d_in[13]; a.dn_g = (const float*)d_in[14];
    a.w_out = (const float*)d_in[15]; a.ln2g = (const float*)d_in[16]; a.ln2b = (const float*)d_in[17]; a.f2w1 = (const float*)d_in[18]; a.f2w3 = (const float*)d_in[19];
    a.f2w2 = (const float*)d_in[20]; a.ln3g = (const float*)d_in[21]; a.ln3b = (const float*)d_in[22];
    (void)fp;
    a.out = (float*)d_out; a.ws = (unsigned char*)d_ws;
    void* args[] = {&a};
    hipError_t e = hipLaunchCooperativeKernel((const void*)fwd_megakernel, dim3(grid_blocks), dim3(NTHREADS), args, LDS_BYTES, stream);
    if (e != hipSuccess) fprintf(stderr, "kernel_launch: cooperative launch failed: %s (grid %d)\n", hipGetErrorString(e), grid_blocks);
}
```

```cpp
#define MIXER 1
#define BARSEL 0
#define DUP 0
#include <hip/hip_runtime.h>
#include <hip/hip_cooperative_groups.h>
#include <cstdio>
#include <cstdint>
namespace pg8 {
#define PG8_LAS __attribute__((address_space(3)))
typedef unsigned short bf16_t;
typedef short bf16x8 __attribute__((ext_vector_type(8)));
typedef float f32x4 __attribute__((ext_vector_type(4)));
typedef unsigned u32x4 __attribute__((ext_vector_type(4)));
constexpr int BM = 256, BK = 64, HALF = 128, HTB = HALF * BK * 2  , STAGE_BYTES = 8 * HTB, NXCD = 8, WGM = 8;

__host__ __device__ __forceinline__ int lds_byte(int r, int c) { const int st = (r >> 4) * 2 + (c >> 5), rr = r & 15, cc = c & 31, ob = rr * 64 + cc * 2; return st * 1024 + (ob ^ (((ob >> 9) & 1) << 5)); }
__host__ __device__ __forceinline__ void stage_rc(int b, int& R, int& C) { const int st = b / 1024, sb = b % 1024, swz = sb ^ (((sb >> 9) & 1) << 5); R = (st >> 1) * 16 + swz / 64; C = (st & 1) * 32 + (swz % 64) / 2; }
__host__ __device__ __forceinline__ int perm32(int rho) { const int n = rho >> 4, i = rho & 15; return 8 * (i >> 2) + 4 * n + (i & 3); }

struct Unit { int pm, pn; };
struct Gemm { const bf16_t* A; const bf16_t* Bt; int M, N, K; };

struct StaticOrder {
    int nM, nN, nwg, G, c;
    __host__ __device__ void init(int M, int N, int G_, int c_) { nM = M / BM; nN = N / BM; nwg = nM * nN; G = G_; c = c_; }
    __host__ __device__ bool next(int i, Unit& u) const {
        const long L = (long)i * G + c; if (L >= nwg) return false;
        int wgid = (int)L; { const int q = nwg / NXCD, r = nwg % NXCD, xcd = wgid % NXCD, off = wgid / NXCD; wgid = (xcd < r ? xcd * (q + 1) : r * (q + 1) + (xcd - r) * q) + off; }
        const int nig = WGM * nN, gid = wgid / nig, fm = gid * WGM, gsz = (nM - fm) < WGM ? (nM - fm) : WGM;
        u.pm = fm + ((wgid % nig) % gsz); u.pn = (wgid % nig) / gsz; return true;
    }
    __device__ __forceinline__ void a_ready(const Unit&) const {}
    __device__ __forceinline__ void done(const Unit&) const {}
};

typedef float f32x2_t __attribute__((ext_vector_type(2))); typedef __bf16 bf16x2_t __attribute__((ext_vector_type(2)));
__device__ __forceinline__ unsigned cvt_pk_bf16(float lo, float hi) { f32x2_t v = {lo, hi}; bf16x2_t b = __builtin_convertvector(v, bf16x2_t); return __builtin_bit_cast(unsigned, b); }
template <class Epi, class Sched, bool ALIGN_EPI = false, bool SP2 = false>
__device__ __forceinline__ void gemm_phase(PG8_LAS unsigned char* lds, const Gemm g, const Sched& S, const Epi& E) {
    int tid_ = threadIdx.x; asm volatile("" : "+v"(tid_));
    const int tid = tid_, wid = __builtin_amdgcn_readfirstlane(tid >> 6), lane = tid & 63, wr = wid >> 2, wc = wid & 3, fr = lane & 15, fq = lane >> 4;
    const int K = g.K, nt = K / BK;
    unsigned voffA[2], voffB[2];
#pragma unroll
    for (int i = 0; i < 2; ++i) { int R, C; stage_rc(tid * 16 + i * 8192, R, C); const int Rb = Epi::PERM ? ((R & ~31) + perm32(R & 31)) : R;
        voffA[i] = (unsigned)(R * K + C) * 2u; voffB[i] = (unsigned)(Rb * K + C) * 2u; }
    const size_t kstep = (size_t)(BK * 2);
    const size_t hstep = (size_t)HALF * K * 2;
    const size_t tstep = 2 * hstep;
    const unsigned ldsw = (unsigned)wid * 1024u;
    const int aoff = lds_byte(wr * 64 + fr, fq * 8), boff = lds_byte(wc * 32 + fr, fq * 8);
#define PG8_SA(b, h) (((b) * 2 + (h)) * HTB)
#define PG8_SB(b, h) ((4 + (b) * 2 + (h)) * HTB)
#define PG8_STAGE(bufoff, gbase, voff) do { _Pragma("unroll") for (int _i = 0; _i < 2; ++_i) \
        __builtin_amdgcn_global_load_lds((const unsigned*)((const char*)(gbase) + (voff)[_i]), (PG8_LAS unsigned*)(lds + (bufoff) + ldsw + _i * 8192), 16, 0, 0); } while (0)
#define PG8_LDA(dst, b, h) do { _Pragma("unroll") for (int m = 0; m < 4; ++m) _Pragma("unroll") for (int k = 0; k < 2; ++k) dst[m][k] = *(const PG8_LAS bf16x8*)(lds + PG8_SA(b, h) + aoff + m * 2048 + k * 1024); } while (0)
#define PG8_LDB(dst, b, h) do { _Pragma("unroll") for (int n = 0; n < 2; ++n) _Pragma("unroll") for (int k = 0; k < 2; ++k) dst[n][k] = *(const PG8_LAS bf16x8*)(lds + PG8_SB(b, h) + boff + n * 2048 + k * 1024); } while (0)
#define PG8_MMA(ai, bj, At, Bt) do { __builtin_amdgcn_s_setprio(1); _Pragma("unroll") for (int m = 0; m < 4; ++m) _Pragma("unroll") for (int n = 0; n < 2; ++n) _Pragma("unroll") for (int k = 0; k < 2; ++k) \
        acc[ai][bj][m][n] = __builtin_amdgcn_mfma_f32_16x16x32_bf16(Bt[n][k], At[m][k], acc[ai][bj][m][n], 0, 0, 0); __builtin_amdgcn_s_setprio(0); } while (0)
#define PG8_WAIT_V(n) asm volatile("s_waitcnt vmcnt(" #n ")" ::: "memory")
#define PG8_WAIT_L(n) asm volatile("s_waitcnt lgkmcnt(" #n ")" ::: "memory")
#define PG8_BAR __builtin_amdgcn_s_barrier()
#define PG8_SCHED __builtin_amdgcn_sched_barrier(0)
    Unit cur, nxt; int ui = 0;
    if (!S.next(0, cur)) return;
    f32x4 acc[2][2][4][2];
#pragma unroll
    for (int a = 0; a < 2; ++a)
#pragma unroll
        for (int b = 0; b < 2; ++b)
#pragma unroll
            for (int m = 0; m < 4; ++m)
#pragma unroll
                for (int n = 0; n < 2; ++n) acc[a][b][m][n] = (f32x4){0.f, 0.f, 0.f, 0.f};
    bf16x8 At[4][2], B0[2][2], B1[2][2];
    const char* cA = (const char*)g.A + (size_t)cur.pm * tstep; const char* cB = (const char*)g.Bt + (size_t)cur.pn * tstep;
    S.a_ready(cur);
    if constexpr (SP2) {
        PG8_STAGE(PG8_SB(0, 0), cB, voffB); PG8_STAGE(PG8_SB(0, 1), cB + hstep, voffB); PG8_STAGE(PG8_SA(0, 0), cA, voffA); PG8_STAGE(PG8_SA(0, 1), cA + hstep, voffA);
        if (wr == 1) PG8_BAR;
        PG8_WAIT_V(2); PG8_BAR;
        PG8_STAGE(PG8_SB(1, 0), cB + kstep, voffB); PG8_STAGE(PG8_SA(1, 0), cA + kstep, voffA); PG8_STAGE(PG8_SB(1, 1), cB + hstep + kstep, voffB);
        PG8_WAIT_V(6); PG8_BAR;
    } else {
        PG8_STAGE(PG8_SB(0, 0), cB, voffB); PG8_STAGE(PG8_SA(0, 0), cA, voffA); PG8_STAGE(PG8_SB(0, 1), cB + hstep, voffB); PG8_STAGE(PG8_SA(0, 1), cA + hstep, voffA);
        if (wr == 1) PG8_BAR;
        PG8_WAIT_V(4); PG8_BAR;
        PG8_STAGE(PG8_SB(1, 0), cB + kstep, voffB); PG8_STAGE(PG8_SA(1, 0), cA + kstep, voffA); PG8_STAGE(PG8_SB(1, 1), cB + hstep + kstep, voffB);
        PG8_WAIT_V(6); PG8_BAR;
    }
    for (;;) {
        const bool has_next = S.next(ui + 1, nxt);
        const char* nA = has_next ? (const char*)g.A + (size_t)nxt.pm * tstep : cA; const char* nB = has_next ? (const char*)g.Bt + (size_t)nxt.pn * tstep : cB;
        for (int t = 0; t < nt; t += 2) {
            const bool last = (t == nt - 2);
            const char* a1 = cA + (size_t)(t + 1) * kstep;
            const char* a2 = last ? nA : cA + (size_t)(t + 2) * kstep; const char* b2 = last ? nB : cB + (size_t)(t + 2) * kstep;
            const char* a3 = a2 + kstep; const char* b3 = b2 + kstep;
            if (last && has_next) S.a_ready(nxt);
            if constexpr (SP2) {
            PG8_LDB(B0, 0, 0); PG8_LDB(B1, 0, 1); PG8_SCHED; PG8_LDA(At, 0, 0); PG8_STAGE(PG8_SA(1, 1), a1 + hstep, voffA);
            PG8_WAIT_V(8); PG8_WAIT_L(0); PG8_BAR; PG8_MMA(0, 0, At, B0); PG8_MMA(0, 1, At, B1); PG8_BAR; PG8_SCHED;
            PG8_LDA(At, 0, 1); PG8_STAGE(PG8_SB(0, 0), b2, voffB); PG8_STAGE(PG8_SB(0, 1), b2 + hstep, voffB); PG8_STAGE(PG8_SA(0, 0), a2, voffA);
            PG8_WAIT_V(8); PG8_WAIT_L(0); PG8_BAR; PG8_MMA(1, 0, At, B0); PG8_MMA(1, 1, At, B1); PG8_BAR; PG8_SCHED;
            PG8_LDB(B0, 1, 0); PG8_LDB(B1, 1, 1); PG8_SCHED; PG8_LDA(At, 1, 0); PG8_STAGE(PG8_SA(0, 1), a2 + hstep, voffA);
            PG8_WAIT_V(8); PG8_WAIT_L(0); PG8_BAR; PG8_MMA(0, 0, At, B0); PG8_MMA(0, 1, At, B1); PG8_BAR; PG8_SCHED;
            PG8_LDA(At, 1, 1); PG8_STAGE(PG8_SB(1, 0), b3, voffB); PG8_STAGE(PG8_SB(1, 1), b3 + hstep, voffB); PG8_STAGE(PG8_SA(1, 0), a3, voffA);
            PG8_WAIT_V(8); PG8_WAIT_L(0); PG8_BAR; PG8_MMA(1, 0, At, B0); PG8_MMA(1, 1, At, B1); PG8_BAR; PG8_SCHED;
            } else {
            PG8_LDB(B0, 0, 0); PG8_SCHED; PG8_LDA(At, 0, 0); PG8_STAGE(PG8_SA(1, 1), a1 + hstep, voffA);
            PG8_WAIT_L(8); PG8_BAR; PG8_WAIT_L(0); PG8_MMA(0, 0, At, B0); PG8_BAR; PG8_SCHED;
            PG8_LDB(B1, 0, 1); PG8_STAGE(PG8_SB(0, 0), b2, voffB);
            PG8_BAR; PG8_WAIT_L(0); PG8_MMA(0, 1, At, B1); PG8_BAR;
            PG8_LDA(At, 0, 1); PG8_STAGE(PG8_SA(0, 0), a2, voffA);
            PG8_BAR; PG8_WAIT_L(0); PG8_MMA(1, 0, At, B0); PG8_BAR; PG8_SCHED;
            PG8_STAGE(PG8_SB(0, 1), b2 + hstep, voffB);
            PG8_WAIT_V(6); PG8_BAR; PG8_MMA(1, 1, At, B1); PG8_BAR;
            PG8_LDB(B0, 1, 0); PG8_SCHED; PG8_LDA(At, 1, 0); PG8_STAGE(PG8_SA(0, 1), a2 + hstep, voffA);
            PG8_WAIT_L(8); PG8_BAR; PG8_WAIT_L(0); PG8_MMA(0, 0, At, B0); PG8_BAR; PG8_SCHED;
            PG8_LDB(B1, 1, 1); PG8_STAGE(PG8_SB(1, 0), b3, voffB);
            PG8_BAR; PG8_WAIT_L(0); PG8_MMA(0, 1, At, B1); PG8_BAR;
            PG8_LDA(At, 1, 1); PG8_STAGE(PG8_SA(1, 0), a3, voffA);
            PG8_BAR; PG8_WAIT_L(0); PG8_MMA(1, 0, At, B0); PG8_BAR; PG8_SCHED;
            PG8_STAGE(PG8_SB(1, 1), b3 + hstep, voffB);
            PG8_WAIT_V(6); PG8_BAR; PG8_MMA(1, 1, At, B1); PG8_BAR;
            }
        }
        if constexpr (ALIGN_EPI) { if (wr == 0) PG8_BAR; }
        if constexpr (!Epi::AFTER_DRAIN) { E(acc, cur, wr, wc, fr, fq); S.done(cur); }
        if (!has_next) break;
#pragma unroll
        for (int a = 0; a < 2; ++a)
#pragma unroll
            for (int b = 0; b < 2; ++b)
#pragma unroll
                for (int m = 0; m < 4; ++m)
#pragma unroll
                    for (int n = 0; n < 2; ++n) acc[a][b][m][n] = (f32x4){0.f, 0.f, 0.f, 0.f};
        cur = nxt; cA = nA; cB = nB; ++ui;
        if constexpr (ALIGN_EPI) { if (wr == 1) PG8_BAR; }
    }
    PG8_WAIT_V(0);
    if constexpr (!ALIGN_EPI) { if (wr == 0) PG8_BAR; }
    PG8_BAR;
    if constexpr (Epi::AFTER_DRAIN) { E.fused(acc, cur, wr, wc, fr, fq, lds, wid, lane); S.done(cur); }
#undef PG8_SA
#undef PG8_SB
#undef PG8_STAGE
#undef PG8_LDA
#undef PG8_LDB
#undef PG8_MMA
#undef PG8_WAIT_V
#undef PG8_WAIT_L
#undef PG8_BAR
#undef PG8_SCHED
}
}
namespace pg8 {
typedef float f32x2 __attribute__((ext_vector_type(2)));
__device__ __forceinline__ float silu_f(float v) { return v * __builtin_amdgcn_rcpf(1.0f + __builtin_amdgcn_exp2f(-1.4426950408889634f * v)); }

struct EpiSwiGLU {
    static constexpr bool PERM = true, AFTER_DRAIN = false;
    bf16_t* O; int ldc;
    __device__ __forceinline__ void operator()(const f32x4 (&acc)[2][2][4][2], const Unit& u, int wr, int wc, int fr, int fq) const {
        const int row0 = u.pm * BM + wr * 64 + fr, col0 = u.pn * HALF + wc * 32 + 8 * fq;
#pragma unroll
        for (int ai = 0; ai < 2; ++ai)
#pragma unroll
            for (int m = 0; m < 4; ++m) {
                bf16_t* rowp = O + (size_t)(row0 + ai * HALF + m * 16) * ldc + col0;
                const f32x4 a0 = acc[ai][0][m][0], a1 = acc[ai][0][m][1], g0 = acc[ai][1][m][0], g1 = acc[ai][1][m][1];
                u32x4 w;
                w.x = cvt_pk_bf16(silu_f(a0[0]) * g0[0], silu_f(a0[1]) * g0[1]); w.y = cvt_pk_bf16(silu_f(a0[2]) * g0[2], silu_f(a0[3]) * g0[3]);
                w.z = cvt_pk_bf16(silu_f(a1[0]) * g1[0], silu_f(a1[1]) * g1[1]); w.w = cvt_pk_bf16(silu_f(a1[2]) * g1[2], silu_f(a1[3]) * g1[3]);
                *(u32x4*)rowp = w;
            }
    }
};

struct EpiResid {
    static constexpr bool PERM = false, AFTER_DRAIN = false;
    const float* X; float* Y; const float* gate; int gate_ld; float coef, alpha;
    __device__ __forceinline__ void operator()(const f32x4 (&acc)[2][2][4][2], const Unit& u, int wr, int wc, int fr, int fq) const {
        const int col0 = u.pn * BM + wc * 32 + 4 * fq; const float* gb = gate + (size_t)(u.pm >> 3) * gate_ld + col0;
        f32x4 gv[2][2];
#pragma unroll
        for (int bj = 0; bj < 2; ++bj)
#pragma unroll
            for (int n = 0; n < 2; ++n) gv[bj][n] = *(const f32x4*)(gb + bj * HALF + n * 16) * coef;
#pragma unroll
        for (int ai = 0; ai < 2; ++ai)
#pragma unroll
            for (int m = 0; m < 4; ++m) { const size_t off = (size_t)(u.pm * BM + ai * HALF + wr * 64 + m * 16 + fr) * 1024 + col0;
#pragma unroll
                for (int bj = 0; bj < 2; ++bj)
#pragma unroll
                    for (int n = 0; n < 2; ++n) { const f32x4 xv = *(const f32x4*)(X + off + bj * HALF + n * 16);
                        *(f32x4*)(Y + off + bj * HALF + n * 16) = xv * alpha + gv[bj][n] * acc[ai][bj][m][n]; }
                if (m & 1) asm volatile("" ::: "memory"); }
    }
};

struct EpiInProj {
    static constexpr bool PERM = true, AFTER_DRAIN = false;
    bf16_t *Q, *QI, *K, *KI, *VT, *B4; float* SM; const float *cs, *sn;
    float qscale, wscale;
    __device__ __forceinline__ void rope_store(const f32x4 (&acc)[2][2][4][2], bf16_t* dst, int ld, int colbase, float sc, int row0, int fq) const {
        typedef unsigned u32x2 __attribute__((ext_vector_type(2)));
#pragma unroll
        for (int ai = 0; ai < 2; ++ai)
#pragma unroll
            for (int m = 0; m < 4; ++m) { const int r = row0 + ai * HALF + m * 16;
                bf16_t* p = dst + (size_t)r * ld + colbase + 8 * fq;
#pragma unroll
                for (int n = 0; n < 2; ++n) {
                    const f32x4 c0 = *(const f32x4*)(cs + (size_t)r * 32 + 8 * fq + 4 * n), s0 = *(const f32x4*)(sn + (size_t)r * 32 + 8 * fq + 4 * n);
                    const f32x4 x0 = acc[ai][0][m][n], y0 = acc[ai][1][m][n];
                    const f32x4 o0 = (x0 * c0 - y0 * s0) * sc, p0 = (y0 * c0 + x0 * s0) * sc;
                    u32x2 w; w.x = cvt_pk_bf16(o0[0], o0[1]); w.y = cvt_pk_bf16(o0[2], o0[3]); *(u32x2*)(p + 4 * n) = w;
                    w.x = cvt_pk_bf16(p0[0], p0[1]); w.y = cvt_pk_bf16(p0[2], p0[3]); *(u32x2*)(p + 32 + 4 * n) = w;
                    asm volatile("" ::: "memory"); } }
    }
    __device__ __forceinline__ void operator()(const f32x4 (&acc)[2][2][4][2], const Unit& u, int wr, int wc, int fr, int fq) const {
        const int row0 = u.pm * BM + wr * 64 + fr; const int pn = u.pn;
        if (pn < 2) { rope_store(acc, Q, 512, ((pn & 1) * 4 + wc) * 64, qscale, row0, fq); }
        else if (pn < 4) { rope_store(acc, QI, 512, ((pn & 1) * 4 + wc) * 64, 1.0f, row0, fq); }
        else if (pn == 4) {
            if (wc == 0) rope_store(acc, K, 64, 0, 1.0f, row0, fq);
            else if (wc == 1) rope_store(acc, KI, 64, 0, 1.0f, row0, fq);
            else if (wc == 2) {
#pragma unroll
                for (int ai = 0; ai < 2; ++ai)
#pragma unroll
                    for (int m = 0; m < 4; ++m) { bf16_t* rowp = VT + (size_t)(row0 + ai * HALF + m * 16) * 64 + 8 * fq;
#pragma unroll
                        for (int bj = 0; bj < 2; ++bj) { const f32x4 v0 = acc[ai][bj][m][0], v1 = acc[ai][bj][m][1]; u32x4 w;
                            w.x = cvt_pk_bf16(v0[0], v0[1]); w.y = cvt_pk_bf16(v0[2], v0[3]); w.z = cvt_pk_bf16(v1[0], v1[1]); w.w = cvt_pk_bf16(v1[2], v1[3]);
                            *(u32x4*)(rowp + bj * 32) = w; } }
            } else {
                if (fq < 2) {
#pragma unroll
                    for (int ai = 0; ai < 2; ++ai)
#pragma unroll
                        for (int m = 0; m < 4; ++m) { const int r = row0 + ai * HALF + m * 16; const float s = (fq == 0) ? wscale : 1.0f;
                            *(f32x4*)(SM + (size_t)r * 16 + 8 * fq) = acc[ai][0][m][0] * s; *(f32x4*)(SM + (size_t)r * 16 + 8 * fq + 4) = acc[ai][0][m][1] * s; }
                }
            }
        } else {
            const int col0 = (pn - 5) * BM + wc * 32 + 8 * fq;
#pragma unroll
            for (int ai = 0; ai < 2; ++ai)
#pragma unroll
                for (int m = 0; m < 4; ++m) { bf16_t* rowp = B4 + (size_t)(row0 + ai * HALF + m * 16) * 2048 + col0;
#pragma unroll
                    for (int bj = 0; bj < 2; ++bj) { const f32x4 v0 = acc[ai][bj][m][0], v1 = acc[ai][bj][m][1]; u32x4 w;
                        w.x = cvt_pk_bf16(v0[0], v0[1]); w.y = cvt_pk_bf16(v0[2], v0[3]); w.z = cvt_pk_bf16(v1[0], v1[1]); w.w = cvt_pk_bf16(v1[2], v1[3]);
                        *(u32x4*)(rowp + bj * HALF) = w; } }
        }
    }
};
}
namespace cg = cooperative_groups;
#define LAS __attribute__((address_space(3)))
typedef unsigned short bf16;
typedef unsigned v4u __attribute__((ext_vector_type(4)));
typedef unsigned v2u __attribute__((ext_vector_type(2)));
typedef float f32x4 __attribute__((ext_vector_type(4)));
typedef float f32x16 __attribute__((ext_vector_type(16)));
typedef short bf16x8 __attribute__((ext_vector_type(8)));
typedef short bf16x4 __attribute__((ext_vector_type(4)));

constexpr int NWAVES = 8, NTHREADS = 512;
constexpr int BATCH = 16, SEQ = 2048, D = 1024, T = BATCH * SEQ, FF = 2816, NMOD = 9216;
constexpr int NIN = 3280, NINP = 3328;
constexpr float LN_EPS = 1e-5f, RMS_EPS = 1e-6f;
constexpr float ALPHA = 1.189207115002721f;
constexpr float LOG2E = 1.4426950408889634f;
constexpr float QSCALE = 0.125f * LOG2E;

constexpr size_t MiB = 1u << 20;
constexpr size_t WS_CTL = 0, CTL_ZERO_BYTES = 64 * 1024;
constexpr size_t WS_MOD = 1 * MiB, WS_COS = 2 * MiB, WS_SIN = 6 * MiB;
constexpr size_t WS_W13A = 10 * MiB, WS_W2A = 21 * MiB, WS_W13B = 27 * MiB, WS_W2B = 38 * MiB, WS_WIN = 44 * MiB, WS_WOUT = 51 * MiB;
constexpr size_t WS_SM = 53 * MiB, WS_K = 55 * MiB, WS_KI = 59 * MiB, WS_VT = 63 * MiB, WS_MASK = 67 * MiB, WS_QI = 75 * MiB, WS_AQK = 107 * MiB, WS_GL = 123 * MiB;
constexpr size_t WS_U = 124 * MiB;
constexpr size_t WS_X = 188 * MiB;
constexpr size_t WS_H = 316 * MiB;
constexpr size_t WS_B4 = WS_H, WS_Q = WS_H + 128 * MiB;
constexpr size_t WS_END = 492 * MiB;
constexpr int CW_QUEUE = 64;

__device__ __forceinline__ unsigned f2bf(float f) { unsigned u = __builtin_bit_cast(unsigned, f); return (u + 0x7fffu + ((u >> 16) & 1u)) >> 16; }
__device__ __forceinline__ unsigned pk2(float lo, float hi) { return f2bf(lo) | (f2bf(hi) << 16); }
__device__ __forceinline__ float bf2f(unsigned short h) { return __builtin_bit_cast(float, (unsigned)h << 16); }
__device__ __forceinline__ float wave_sum(float v) {
#pragma unroll
    for (int o = 1; o < 64; o <<= 1) v += __shfl_xor(v, o);
    return v;
}
#define LDS_WAIT() asm volatile("s_waitcnt lgkmcnt(0)" ::: "memory")

struct Args {
    const float *x, *c; const int* pos; const float *w_ada, *b_ada, *f1w1, *f1w3, *f1w2, *ln1g, *ln1b, *w_in, *conv_w, *a_log, *dt_bias, *dn_g, *w_out, *ln2g, *ln2b, *f2w1, *f2w3, *f2w2, *ln3g, *ln3b;
    float* out; unsigned char* ws;
};

__device__ __forceinline__ void p0_mod(const Args& A, LAS unsigned char* lds, int tid, int wave, int lane, int bid, int G) {
    LAS float* sc = (LAS float*)lds;
    LAS float* red = (LAS float*)(lds + 65536);
    float* mod = (float*)(A.ws + WS_MOD);
    bool have_sc = false;
    for (int task = bid; task < NMOD / 32; task += G) {
        if (!have_sc) { for (int i = tid; i < 16 * 1024; i += NTHREADS) { const float v = A.c[i]; sc[i] = v / (1.0f + __expf(-v)); } have_sc = true; __syncthreads(); }
        const int col = lane & 31, half = lane >> 5, j0 = task * 32;
        float acc[16];
#pragma unroll
        for (int b = 0; b < 16; ++b) acc[b] = 0.f;
#pragma unroll 4
        for (int i = 0; i < 64; ++i) { const int k = wave * 128 + 2 * i + half; const float wv = A.w_ada[(size_t)k * NMOD + j0 + col];
#pragma unroll
            for (int b = 0; b < 16; ++b) acc[b] += sc[b * 1024 + k] * wv; }
#pragma unroll
        for (int b = 0; b < 16; ++b) red[((wave * 2 + half) * 16 + b) * 32 + col] = acc[b];
        __syncthreads();
        { const int b = tid >> 5, cc = tid & 31; float s = A.b_ada[j0 + cc];
#pragma unroll
            for (int p = 0; p < 16; ++p) s += red[(p * 16 + b) * 32 + cc];
            mod[b * NMOD + j0 + cc] = s; }
        __syncthreads();
    }
}

template <class F>
__device__ __forceinline__ void transpose_item(const float* W, int K, int N, bf16* WT, F dstrow, LAS float* scr, int item, int lane) {
    const int nblk = (N + 31) / 32, kb = item / nblk, nb = item % nblk, k0 = 64 * kb, n0 = 32 * nb;
    const bool nok = (n0 + (lane & 31)) < N;
#pragma unroll 8
    for (int i = 0; i < 32; ++i) { const int kk = 2 * i + (lane >> 5); scr[kk * 33 + (lane & 31)] = nok ? W[(size_t)(k0 + kk) * N + n0 + (lane & 31)] : 0.f; }
    LDS_WAIT(); asm volatile("" ::: "memory");
    const int c = lane & 7;
#pragma unroll
    for (int j = 0; j < 4; ++j) { const int n = (lane >> 3) + 8 * j; const LAS float* s = scr + (8 * c) * 33 + n;
        v4u o; o.x = pk2(s[0 * 33], s[1 * 33]); o.y = pk2(s[2 * 33], s[3 * 33]); o.z = pk2(s[4 * 33], s[5 * 33]); o.w = pk2(s[6 * 33], s[7 * 33]);
        const int dr = (n0 + n < N) ? dstrow(n0 + n) : -1;
        if (dr >= 0) *(v4u*)(WT + (size_t)dr * K + k0 + 8 * c) = o; }
    LDS_WAIT(); asm volatile("" ::: "memory");
}
__device__ __forceinline__ int win_dst(int n) {
    if (n < 512) { const int head = n >> 6, d = n & 63; return 256 * (head >> 2) + 128 * (d >> 5) + 32 * (head & 3) + (d & 31); }
    if (n < 576) { const int d = n - 512; return 1024 + 128 * (d >> 5) + (d & 31); }
    if (n < 640) { const int d = n - 576; return 1024 + 128 * (d >> 5) + 64 + (d & 31); }
    if (n < 1152) { const int j = n - 640, head = j >> 6, d = j & 63; return 256 * (2 + (head >> 2)) + 128 * (d >> 5) + 32 * (head & 3) + (d & 31); }
    if (n < 1216) { const int d = n - 1152; return 1024 + 128 * (d >> 5) + 32 + (d & 31); }
    if (n < 1224) return 1024 + 96 + (n - 1216);
    if (n < 3272) return 1280 + (n - 1224);
    if (n < 3276) return 1024 + 96 + 8 + (n - 3272);
    return 1024 + 96 + 12 + (n - 3276);
}
__device__ __forceinline__ void p0_weights(const Args& A, LAS unsigned char* lds, int wave, int lane, int bid, int G) {
    LAS float* scr = (LAS float*)(lds + wave * 16384);
    const int gw = bid * NWAVES + wave, NGW = G * NWAVES;
    constexpr int I_13 = (D / 64) * (FF / 32), I_2 = (FF / 64) * (D / 32), I_IN = (D / 64) * ((NIN + 31) / 32), I_OUT = (D / 64) * (D / 32);
    constexpr int NITEMS = 4 * I_13 + 2 * I_2 + I_IN + I_OUT;
    bf16* W13A = (bf16*)(A.ws + WS_W13A); bf16* W2A = (bf16*)(A.ws + WS_W2A); bf16* W13B = (bf16*)(A.ws + WS_W13B); bf16* W2B = (bf16*)(A.ws + WS_W2B);
    bf16* WIN = (bf16*)(A.ws + WS_WIN); bf16* WOUT = (bf16*)(A.ws + WS_WOUT);
    auto d1 = [](int n) { return (n >> 7) * 256 + (n & 127); };
    auto d3 = [](int n) { return (n >> 7) * 256 + 128 + (n & 127); };
    auto id = [](int n) { return n; };
    for (int it = gw; it < NITEMS; it += NGW) {
        int r = it;
        if (r < I_13) { transpose_item(A.f1w1, D, FF, W13A, d1, scr, r, lane); continue; } r -= I_13;
        if (r < I_13) { transpose_item(A.f1w3, D, FF, W13A, d3, scr, r, lane); continue; } r -= I_13;
        if (r < I_13) { transpose_item(A.f2w1, D, FF, W13B, d1, scr, r, lane); continue; } r -= I_13;
        if (r < I_13) { transpose_item(A.f2w3, D, FF, W13B, d3, scr, r, lane); continue; } r -= I_13;
        if (r < I_2) { transpose_item(A.f1w2, FF, D, W2A, id, scr, r, lane); continue; } r -= I_2;
        if (r < I_2) { transpose_item(A.f2w2, FF, D, W2B, id, scr, r, lane); continue; } r -= I_2;
        if (r < I_IN) { transpose_item(A.w_in, D, NIN, WIN, [](int n) { return win_dst(n); }, scr, r, lane); continue; } r -= I_IN;
        transpose_item(A.w_out, D, D, WOUT, id, scr, r, lane);
    }
    for (int i = gw * 64 + lane; i < 48 * 128; i += NGW * 64) { const int rr = i >> 7, ch = i & 127; const int row = rr < 16 ? 1136 + rr : 1248 + (rr - 16);
        *(v4u*)(WIN + (size_t)row * D + ch * 8) = (v4u){0u, 0u, 0u, 0u}; }
}
__device__ __forceinline__ void p0_rope(const Args& A, int tid, int bid, int G) {
    float* cs = (float*)(A.ws + WS_COS); float* sn = (float*)(A.ws + WS_SIN);
    for (int i = bid * NTHREADS + tid; i < T * 32; i += G * NTHREADS) {
        const int t = i >> 5, j = i & 31;
        const float inv = (float)exp2(-(double)j * (13.287712379549449 / 32.0));
        const float ang = (float)A.pos[t] * inv;
        const double x = (double)ang; const double q = rint(x * 0.6366197723675814); const double y = x - q * 1.5707963267948966;
        const double y2 = y * y;
        const double sy = y * (1.0 + y2 * (-1.0 / 6 + y2 * (1.0 / 120 + y2 * (-1.0 / 5040 + y2 * (1.0 / 362880 + y2 * (-1.0 / 39916800 + y2 * (1.0 / 6227020800.0)))))));
        const double cy = 1.0 + y2 * (-0.5 + y2 * (1.0 / 24 + y2 * (-1.0 / 720 + y2 * (1.0 / 40320 + y2 * (-1.0 / 3628800 + y2 * (1.0 / 479001600 + y2 * (-1.0 / 87178291200.0)))))));
        const int qi = ((int)q) & 3;
        const double sv = (qi == 0) ? sy : (qi == 1) ? cy : (qi == 2) ? -sy : -cy;
        const double cv = (qi == 0) ? cy : (qi == 1) ? -sy : (qi == 2) ? -cy : sy;
        cs[i] = (float)cv; sn[i] = (float)sv;
    }
}
template <int CTRL> __device__ __forceinline__ float dppf(float v) { return __builtin_bit_cast(float, __builtin_amdgcn_update_dpp(0, __builtin_bit_cast(int, v), CTRL, 0xf, 0xf, true)); }
__device__ __forceinline__ float wave_sum_fast(float x) {
    x += dppf<0xB1>(x); x += dppf<0x4E>(x); x += dppf<0x141>(x); x += dppf<0x140>(x);
    x += __shfl_xor(x, 16); x += __shfl_xor(x, 32); return x; }
constexpr int ROWS_PER_WAVE = 16;
__device__ __forceinline__ void p_modulate_rows(const float* X, bf16* U, const float* mod, int sh_off, int sc_off, int wave, int lane, int bid, int G) {
    asm volatile("" : "+v"(lane));
    const int gw = bid * NWAVES + wave, NGW = G * NWAVES;
    for (int blk = gw; blk < T / ROWS_PER_WAVE; blk += NGW) { const int m0 = blk * ROWS_PER_WAVE; const int b = m0 >> 11; const float* mb = mod + (size_t)b * NMOD;
        f32x4 sh[4], sc[4];
#pragma unroll
        for (int j = 0; j < 4; ++j) { sh[j] = *((const f32x4*)(mb + sh_off) + lane + 64 * j); sc[j] = *((const f32x4*)(mb + sc_off) + lane + 64 * j) + 1.0f; }
        f32x4 v[4], nx[4];
#pragma unroll
        for (int j = 0; j < 4; ++j) v[j] = *((const f32x4*)(X + (size_t)m0 * D) + lane + 64 * j);
        for (int r = 0; r < ROWS_PER_WAVE; ++r) { const int m = m0 + r;
            if (r + 1 < ROWS_PER_WAVE) {
#pragma unroll
                for (int j = 0; j < 4; ++j) nx[j] = *((const f32x4*)(X + (size_t)(m + 1) * D) + lane + 64 * j); }
            unsigned long long* o8 = (unsigned long long*)(U + (size_t)m * D) + lane;
#pragma unroll
            for (int j = 0; j < 4; ++j) { const f32x4 u = v[j] * sc[j] + sh[j]; o8[64 * j] = (unsigned long long)pk2(u.x, u.y) | ((unsigned long long)pk2(u.z, u.w) << 32); }
#pragma unroll
            for (int j = 0; j < 4; ++j) v[j] = nx[j]; } }
}
__device__ __forceinline__ void p_ln_rows(const float* Y, float* XO, bf16* U, const float* g, const float* bb, const float* mod, int sh_off, int sc_off, int wave, int lane, int bid, int G) {
    asm volatile("" : "+v"(lane));
    const int gw = bid * NWAVES + wave, NGW = G * NWAVES;
    f32x4 gg[4], be[4];
#pragma unroll
    for (int j = 0; j < 4; ++j) { gg[j] = *((const f32x4*)g + lane + 64 * j); be[j] = *((const f32x4*)bb + lane + 64 * j); }
    for (int blk = gw; blk < T / ROWS_PER_WAVE; blk += NGW) { const int m0 = blk * ROWS_PER_WAVE; const int b = m0 >> 11; const float* mb = mod + (size_t)b * NMOD;
        f32x4 sh[4], sc[4];
        if (U) {
#pragma unroll
            for (int j = 0; j < 4; ++j) { sh[j] = *((const f32x4*)(mb + sh_off) + lane + 64 * j); sc[j] = *((const f32x4*)(mb + sc_off) + lane + 64 * j) + 1.0f; } }
        f32x4 v[4], nx[4];
#pragma unroll
        for (int j = 0; j < 4; ++j) v[j] = *((const f32x4*)(Y + (size_t)m0 * D) + lane + 64 * j);
        for (int r = 0; r < ROWS_PER_WAVE; ++r) { const int m = m0 + r;
            if (r + 1 < ROWS_PER_WAVE) {
#pragma unroll
                for (int j = 0; j < 4; ++j) nx[j] = *((const f32x4*)(Y + (size_t)(m + 1) * D) + lane + 64 * j); }
            float s = 0.f;
#pragma unroll
            for (int j = 0; j < 4; ++j) s += (v[j].x + v[j].y) + (v[j].z + v[j].w);
            const float mean = wave_sum_fast(s) * (1.f / D); float s2 = 0.f;
#pragma unroll
            for (int j = 0; j < 4; ++j) { v[j] = v[j] - mean; s2 += (v[j].x * v[j].x + v[j].y * v[j].y) + (v[j].z * v[j].z + v[j].w * v[j].w); }
            const float rstd = 1.f / sqrtf(wave_sum_fast(s2) * (1.f / D) + LN_EPS);
#pragma unroll
            for (int j = 0; j < 4; ++j) { const f32x4 xo = v[j] * rstd * gg[j] + be[j];
                if (XO) *((f32x4*)(XO + (size_t)m * D) + lane + 64 * j) = xo;
                if (U) { const f32x4 u = xo * sc[j] + sh[j]; *((unsigned long long*)(U + (size_t)m * D) + lane + 64 * j) = (unsigned long long)pk2(u.x, u.y) | ((unsigned long long)pk2(u.z, u.w) << 32); } }
#pragma unroll
            for (int j = 0; j < 4; ++j) v[j] = nx[j]; } }
}
#define RLX_AGENT __ATOMIC_RELAXED, __HIP_MEMORY_SCOPE_AGENT
struct XcdBarrier { unsigned* ctr; unsigned epoch; unsigned G; };
__device__ __forceinline__ void xcd_barrier(XcdBarrier& b) {
    asm volatile("s_waitcnt vmcnt(0)" ::: "memory");
    __syncthreads();
    b.epoch += 1u;
    if (threadIdx.x == 0) {
        __builtin_amdgcn_fence(__ATOMIC_RELEASE, "agent");
        asm volatile("s_waitcnt vmcnt(0)" ::: "memory");
        __hip_atomic_fetch_add(b.ctr, 1u, __ATOMIC_RELAXED, __HIP_MEMORY_SCOPE_AGENT);
        const unsigned want = b.epoch * b.G;
        while (__hip_atomic_load(b.ctr, __ATOMIC_RELAXED, __HIP_MEMORY_SCOPE_AGENT) < want) __builtin_amdgcn_s_sleep(2);
#ifdef BAR_DELAY
        for (int i = 0; i < BAR_DELAY; ++i) __builtin_amdgcn_s_sleep(127);
#endif
        __builtin_amdgcn_fence(__ATOMIC_ACQUIRE, "agent");
        asm volatile("s_waitcnt vmcnt(0)" ::: "memory");
    }
    __syncthreads();
}
#include <hip/hip_bf16.h>
#include <cmath>
namespace attn_body {
using bf16=__hip_bfloat16;
using bf16x8=__attribute__((ext_vector_type(8)))short;
using s16x4=__attribute__((ext_vector_type(4)))short;
using f32x16=__attribute__((ext_vector_type(16)))float;
using u32x4=__attribute__((ext_vector_type(4)))unsigned;
constexpr int BATCH=16,NHEAD=8,SEQ=2048,D=64,QP=512,KP=64,OP=1024;
constexpr int NW=8,QBLK=32,QB=QBLK*NW,KVBLK=64,NQB=SEQ/QB;
constexpr int ATTN_UNIT_ROWS=QB;
__device__ __forceinline__ int crow(int r,int hi){return (r&3)+8*(r>>2)+4*hi;}
#define SBAR() __builtin_amdgcn_sched_barrier(0)
typedef unsigned v2u_t __attribute__((ext_vector_type(2)));
__device__ __forceinline__ void kmask(f32x16&p0,f32x16&p1,v2u_t mw,int hi){
  const unsigned w0=mw.x>>(4*hi),w1=mw.y>>(4*hi);
  #pragma unroll
  for(int r=0;r<16;++r){const int c=(r&3)+8*(r>>2);
    const int m0=((int)(w0<<(31-c)))>>31,m1=((int)(w1<<(31-c)))>>31;
    const float a0=p0[r],a1=p1[r];
    const int i0=(__float_as_int(a0)&m0)|(~m0&(int)0xff800000),i1=(__float_as_int(a1)&m1)|(~m1&(int)0xff800000);
    p0[r]=__int_as_float(i0);p1[r]=__int_as_float(i1);}
}

constexpr int NSLOT=3, SLOTB=8192;
constexpr int LDS_K=0, LDS_V=NSLOT*SLOTB, LDS_WS=2*NSLOT*SLOTB, LDS_OST=LDS_WS+NW*64*4, LDS_BYTES=LDS_OST+NW*4096;
constexpr float C2=0.125f*1.4426950408889634f;
__device__ __forceinline__ void glds16(const void*gsrc,unsigned lds_dst){unsigned keep;
  asm volatile("s_mov_b32 %0, m0\n\ts_mov_b32 m0, %2\n\ts_nop 0\n\tglobal_load_lds_dwordx4 %1, off\n\ts_mov_b32 m0, %0":"=&s"(keep):"v"(gsrc),"s"(lds_dst):"memory");}
__device__ __forceinline__ float max3f(float a,float b,float c){float r;asm("v_max3_f32 %0, %1, %2, %3":"=v"(r):"v"(a),"v"(b),"v"(c));return r;}
__device__ __forceinline__ float max2f(float a,float b){float r;asm("v_max_f32_e32 %0, %1, %2":"=v"(r):"v"(a),"v"(b));return r;}
__device__ __forceinline__ float fadd_s(float a,float b){float r;asm("v_add_f32_e32 %0, %1, %2":"=v"(r):"v"(a),"v"(b));return r;}
__device__ __forceinline__ float fsub_s(float a,float b){float r;asm("v_sub_f32_e32 %0, %1, %2":"=v"(r):"v"(a),"v"(b));return r;}
typedef float f32x2_t __attribute__((ext_vector_type(2))); typedef __bf16 bf16x2_t __attribute__((ext_vector_type(2)));
__device__ __forceinline__ unsigned cvtpk_s(float lo,float hi){f32x2_t v={lo,hi};bf16x2_t b=__builtin_convertvector(v,bf16x2_t);return __builtin_bit_cast(unsigned,b);}
#define WAIT_BAR(N) asm volatile("s_waitcnt vmcnt(" #N ") lgkmcnt(0)\n\ts_barrier":::"memory")

__device__ __forceinline__ void qkt(f32x16&p0,f32x16&p1,const char*Kslot,const bf16x8*qr,const f32x16&negm,int r32,int hi){
  const char*kb=Kslot+hi*1024+r32*16;
  #pragma unroll
  for(int d0=0;d0<4;++d0){
    const bf16x8 b0=*reinterpret_cast<const bf16x8*>(kb+d0*2048);
    const bf16x8 b1=*reinterpret_cast<const bf16x8*>(kb+d0*2048+512);
    if(d0==0){p0=__builtin_amdgcn_mfma_f32_32x32x16_bf16(b0,qr[0],negm,0,0,0);p1=__builtin_amdgcn_mfma_f32_32x32x16_bf16(b1,qr[0],negm,0,0,0);}
    else{p0=__builtin_amdgcn_mfma_f32_32x32x16_bf16(b0,qr[d0],p0,0,0,0);p1=__builtin_amdgcn_mfma_f32_32x32x16_bf16(b1,qr[d0],p1,0,0,0);}}
}
typedef __attribute__((address_space(3))) const char* lds_cptr;
typedef short v4i16_t __attribute__((ext_vector_type(4)));
__device__ __forceinline__ void kload8(bf16x8*kf,lds_cptr kp){
  kf[0]=*(const __attribute__((address_space(3))) bf16x8*)(kp);      kf[1]=*(const __attribute__((address_space(3))) bf16x8*)(kp+512);
  kf[2]=*(const __attribute__((address_space(3))) bf16x8*)(kp+2048); kf[3]=*(const __attribute__((address_space(3))) bf16x8*)(kp+2560);
  kf[4]=*(const __attribute__((address_space(3))) bf16x8*)(kp+4096); kf[5]=*(const __attribute__((address_space(3))) bf16x8*)(kp+4608);
  kf[6]=*(const __attribute__((address_space(3))) bf16x8*)(kp+6144); kf[7]=*(const __attribute__((address_space(3))) bf16x8*)(kp+6656);
}
__device__ __forceinline__ void kload2(bf16x8*kf,lds_cptr kp,int j){ kf[2*j]=*(const __attribute__((address_space(3))) bf16x8*)(kp+j*2048); kf[2*j+1]=*(const __attribute__((address_space(3))) bf16x8*)(kp+j*2048+512); }
__device__ __forceinline__ s16x4 vtr(lds_cptr p){ return __builtin_bit_cast(s16x4,__builtin_amdgcn_ds_read_tr16_b64_v4i16((__attribute__((address_space(3))) v4i16_t*)p)); }
__device__ __forceinline__ float rowmax(const f32x16&p0,const f32x16&p1){
  float a=max3f(p0[0],p0[1],p1[0]),b=max3f(p0[2],p0[3],p1[1]);a=max3f(a,p1[2],p1[3]);
  #pragma unroll
  for(int r=4;r<16;r+=4){a=max3f(a,p0[r],p0[r+1]);b=max3f(b,p0[r+2],p0[r+3]);a=max3f(a,p1[r],p1[r+1]);b=max3f(b,p1[r+2],p1[r+3]);}
  const float m=max2f(a,b);
  auto rr=__builtin_amdgcn_permlane32_swap(__float_as_uint(m),__float_as_uint(m),false,false);
  return max2f(__uint_as_float(rr[0]),__uint_as_float(rr[1]));
}
__device__ __forceinline__ void pv(f32x16*o,int vb,bf16x8 pa0,bf16x8 pa1,bf16x8 pa2,bf16x8 pa3){
  #pragma unroll
  for(int d0=0;d0<2;++d0){s16x4 lo[4],hi[4];
    #pragma unroll
    for(int ks=0;ks<4;++ks){
      asm volatile("ds_read_b64_tr_b16 %0,%1 offset:%c2":"=&v"(lo[ks]):"v"(vb),"i"(d0*4096+ks*1024):"memory");
      asm volatile("ds_read_b64_tr_b16 %0,%1 offset:%c2":"=&v"(hi[ks]):"v"(vb),"i"(d0*4096+ks*1024+512):"memory");}
    asm volatile("s_waitcnt lgkmcnt(0)":::"memory");SBAR();
    #define PK(k) (bf16x8){lo[k][0],lo[k][1],lo[k][2],lo[k][3],hi[k][0],hi[k][1],hi[k][2],hi[k][3]}
    o[d0]=__builtin_amdgcn_mfma_f32_32x32x16_bf16(pa0,PK(0),o[d0],0,0,0);
    o[d0]=__builtin_amdgcn_mfma_f32_32x32x16_bf16(pa1,PK(1),o[d0],0,0,0);
    o[d0]=__builtin_amdgcn_mfma_f32_32x32x16_bf16(pa2,PK(2),o[d0],0,0,0);
    o[d0]=__builtin_amdgcn_mfma_f32_32x32x16_bf16(pa3,PK(3),o[d0],0,0,0);
    #undef PK
  }
}

#ifndef ATTN_STORE16
#define ATTN_STORE16(p,v) (*(u32x4*)(p)=(v))
#endif
template<int THRL> __device__ __forceinline__ void attn_unit(int b,int h,int qb,const bf16*Q,const bf16*K,const bf16*V,bf16*O,const unsigned*MASK,char*shm){
  const int tid=threadIdx.x,lane=tid&63,r32=lane&31,hi=lane>>5; const int wid=__builtin_amdgcn_readfirstlane(tid>>6);
  const long rowbase=(long)b*SEQ; const int q0=qb*QB;
  const bf16*Qw=Q+(rowbase+q0+wid*QBLK)*QP+h*D;
  const bf16*Kh=K+rowbase*KP,*Vh=V+rowbase*KP;
  const unsigned lds0=(unsigned)(uintptr_t)shm;
  float*wsf=(float*)(shm+LDS_WS)+wid*64;
  const bf16*ksrc=Kh+(long)lane*KP+wid*8;
  const bf16*vsrc=Vh+(long)(16*(wid&3)+(lane>>2))*KP+(wid>>2)*32+(lane&3)*8;
  const unsigned kdst=lds0+LDS_K+wid*1024, vdst=lds0+LDS_V+wid*1024;
  #define DMA_K(t,slot) glds16(ksrc+(long)(t)*KVBLK*KP,(unsigned)__builtin_amdgcn_readfirstlane(kdst+(slot)))
  #define DMA_V(t,slot) glds16(vsrc+(long)(t)*KVBLK*KP,(unsigned)__builtin_amdgcn_readfirstlane(vdst+(slot)))
  const int vb0=(int)(lds0+LDS_V)+((lane>>4)&1)*32+(lane&3)*8+(4*hi+((lane&15)>>2))*64;
  const char*Kbase=shm+LDS_K; bf16x8 kf[8];
  const lds_cptr shm3=(lds_cptr)shm; const lds_cptr kp0=shm3+LDS_K+hi*1024+r32*16; const lds_cptr vp0=shm3+LDS_V+((lane>>4)&1)*32+(lane&3)*8+(4*hi+((lane&15)>>2))*64;
  const int NT=(q0+QB)/KVBLK;
  DMA_K(0,0);DMA_V(0,0);DMA_K(1,SLOTB);
  bf16x8 qr[4];
  #pragma unroll
  for(int d0=0;d0<4;++d0)qr[d0]=*reinterpret_cast<const bf16x8*>(&Qw[(long)r32*QP+d0*16+hi*8]);
  float mhat=0.f,l_reg=0.f;f32x16 o[2];o[0]=f32x16{};o[1]=f32x16{};f32x16 negm=f32x16{};asm volatile("":"+v"(negm));
  const unsigned*mptr=MASK+(rowbase+q0+wid*QBLK+r32)*64; v2u_t mw_nxt=*(const v2u_t*)mptr;
  #define CMASK(P0,P1,t) do{ const v2u_t mw_=mw_nxt; { const int tn_=((t)+1<NT)?(t)+1:(NT-1); mw_nxt=*(const v2u_t*)(mptr+2*tn_); } kmask(P0,P1,mw_,hi); }while(0)
  bool resc=false;
  #define START(P0,P1) do{ const float rm=rowmax(P0,P1); resc=false; \
    { const float dl=max2f(rm,-60.f); mhat=fadd_s(mhat,dl); \
      _Pragma("unroll") for(int r=0;r<16;++r){P0[r]=fsub_s(P0[r],dl);P1[r]=fsub_s(P1[r],dl);} \
      _Pragma("unroll") for(int r=0;r<16;++r)negm[r]=-mhat; asm volatile("":"+v"(negm)); } \
    _Pragma("unroll") for(int r=0;r<16;++r)P0[r]=__builtin_amdgcn_exp2f(P0[r]); }while(0)
  #define RESC() do{ if(resc){ asm volatile("s_waitcnt lgkmcnt(0)":::"memory"); \
      _Pragma("unroll") for(int d_=0;d_<2;++d_) _Pragma("unroll") for(int r=0;r<16;++r)o[d_][r]*=wsf[crow(r,hi)]; } }while(0)
  f32x16 pA0,pA1,pB0,pB1;
  int sl_prev=0,sl_cur=0,sl_next=SLOTB;
  #define ROT() do{sl_prev=sl_cur;sl_cur=sl_next;sl_next=(sl_next==(NSLOT-1)*SLOTB)?0:sl_next+SLOTB;}while(0)
  DMA_K(2,2*SLOTB);
  WAIT_BAR(3);
  qkt(pA0,pA1,Kbase,qr,negm,r32,hi);asm volatile("s_nop 15\n\ts_nop 7":"+v"(pA0),"+v"(pA1));CMASK(pA0,pA1,0);
  START(pA0,pA1);
  _Pragma("unroll") for(int r=0;r<16;++r)pA1[r]=__builtin_amdgcn_exp2f(pA1[r]);
  WAIT_BAR(0);
  DMA_K(3,0);DMA_V(1,SLOTB);
  ROT();
  kload8(kf,kp0+sl_cur);
  WAIT_BAR(2);
  s16x4 vlo[8],vhi[8]; u32x4 pw0,pw1,pw2,pw3;
  #define PKW(P,B) cvtpk_s(P[B],P[B+1])
  #define PAF(k) __builtin_bit_cast(bf16x8,pw##k)
  #define VFR(i) (bf16x8){vlo[i][0],vlo[i][1],vlo[i][2],vlo[i][3],vhi[i][0],vhi[i][1],vhi[i][2],vhi[i][3]}
  #define PIN(x) asm volatile("":"+v"(x))
  #define MX3(a,b,c) __builtin_fmaxf(__builtin_fmaxf((a),(b)),(c))
  #define GAPA(MF,A0,A1,A2,A3,W0,W1,PW) do{ MF; sacc+=A0; sacc+=A1; sacc+=A2; sacc+=A3; PIN(sacc); W0; W1; PIN(PW); SBAR(); }while(0)
  #define EX(v) __builtin_amdgcn_exp2f(v)
  #define GAPB(MF,X,B) do{ MF; X[B]=EX(X[B]); X[B+1]=EX(X[B+1]); X[B+2]=EX(X[B+2]); X[B+3]=EX(X[B+3]); PIN(X); SBAR(); }while(0)
  #define VRD(i) do{ vlo[i]=vtr(vp_+(((i)>>2)*4096+((i)&3)*1024)); vhi[i]=vtr(vp_+(((i)>>2)*4096+((i)&3)*1024+512)); }while(0)
  #define KRD(G,j) do{ if(G){ kload2(kf,kp0+sl_next,j); SBAR(); } }while(0)
  #define STEP(C0,C1,P0,P1,t,GK,GV,GL) do{ SBAR(); \
    const lds_cptr vp_=vp0+sl_prev; \
    VRD(0); SBAR(); float sacc=(P0[0]+P0[1]); \
    GAPA(C0=__builtin_amdgcn_mfma_f32_32x32x16_bf16(kf[0],qr[0],negm,0,0,0), P0[2],P0[3],P0[4],P0[5],     pw0[0]=PKW(P0,0), pw0[1]=PKW(P0,2), pw0); \
    VRD(4); SBAR(); GAPA(C1=__builtin_amdgcn_mfma_f32_32x32x16_bf16(kf[1],qr[0],negm,0,0,0), P0[6],P0[7],P0[8],P0[9],     pw0[2]=PKW(P0,4), pw0[3]=PKW(P0,6), pw0); \
    VRD(1); SBAR(); GAPA(C0=__builtin_amdgcn_mfma_f32_32x32x16_bf16(kf[2],qr[1],C0,0,0,0),   P0[10],P0[11],P0[12],P0[13], pw1[0]=PKW(P0,8), pw1[1]=PKW(P0,10), pw1); \
    VRD(5); SBAR(); GAPA(C1=__builtin_amdgcn_mfma_f32_32x32x16_bf16(kf[3],qr[1],C1,0,0,0),   P0[14],P0[15],P1[0],P1[1],   pw1[2]=PKW(P0,12),pw1[3]=PKW(P0,14), pw1); \
    VRD(2); SBAR(); GAPA(C0=__builtin_amdgcn_mfma_f32_32x32x16_bf16(kf[4],qr[2],C0,0,0,0),   P1[2],P1[3],P1[4],P1[5],     pw2[0]=PKW(P1,0), pw2[1]=PKW(P1,2), pw2); \
    VRD(6); SBAR(); GAPA(C1=__builtin_amdgcn_mfma_f32_32x32x16_bf16(kf[5],qr[2],C1,0,0,0),   P1[6],P1[7],P1[8],P1[9],     pw2[2]=PKW(P1,4), pw2[3]=PKW(P1,6), pw2); \
    VRD(3); SBAR(); GAPA(C0=__builtin_amdgcn_mfma_f32_32x32x16_bf16(kf[6],qr[3],C0,0,0,0),   P1[10],P1[11],P1[12],P1[13], pw3[0]=PKW(P1,8), pw3[1]=PKW(P1,10), pw3); \
    VRD(7); SBAR(); GAPA(C1=__builtin_amdgcn_mfma_f32_32x32x16_bf16(kf[7],qr[3],C1,0,0,0),   P1[14],P1[15],0.f,0.f,       pw3[2]=PKW(P1,12),pw3[3]=PKW(P1,14), pw3); \
    l_reg+=sacc; \
    if(GK){DMA_K((t)+3,sl_cur);} if(GV){DMA_V((t)+1,sl_next);} \
    CMASK(C0,C1,t); \
    { float a=MX3(C0[0],C0[1],C1[0]),b=MX3(C0[2],C0[3],C1[1]); a=MX3(a,C1[2],C1[3]); \
      _Pragma("unroll") for(int r=4;r<16;r+=4){a=MX3(a,C0[r],C0[r+1]);b=MX3(b,C0[r+2],C0[r+3]);a=MX3(a,C1[r],C1[r+1]);b=MX3(b,C1[r+2],C1[r+3]);} \
      float rm=__builtin_fmaxf(a,b); { auto rr=__builtin_amdgcn_permlane32_swap(__float_as_uint(rm),__float_as_uint(rm),false,false); rm=__builtin_fmaxf(__uint_as_float(rr[0]),__uint_as_float(rr[1])); } \
      resc=false; \
      if(__builtin_expect(__any(rm>(float)THRL),0)){ const float dl=__builtin_fmaxf(rm,0.f); mhat+=dl; \
        _Pragma("unroll") for(int r=0;r<16;++r){C0[r]-=dl;C1[r]-=dl;} \
        _Pragma("unroll") for(int r=0;r<16;++r)negm[r]=-mhat; asm volatile("":"+v"(negm)); \
        const float f=__builtin_amdgcn_exp2f(-dl); l_reg*=f; if(hi==0)wsf[r32]=f; resc=true; } } \
    SBAR(); \
    GAPB(o[0]=__builtin_amdgcn_mfma_f32_32x32x16_bf16(PAF(0),VFR(0),o[0],0,0,0), C0,0); \
    GAPB(o[1]=__builtin_amdgcn_mfma_f32_32x32x16_bf16(PAF(0),VFR(4),o[1],0,0,0), C0,4); \
    KRD(GL,0); GAPB(o[0]=__builtin_amdgcn_mfma_f32_32x32x16_bf16(PAF(1),VFR(1),o[0],0,0,0), C0,8); \
    KRD(GL,1); GAPB(o[1]=__builtin_amdgcn_mfma_f32_32x32x16_bf16(PAF(1),VFR(5),o[1],0,0,0), C0,12); \
    KRD(GL,2); GAPB(o[0]=__builtin_amdgcn_mfma_f32_32x32x16_bf16(PAF(2),VFR(2),o[0],0,0,0), C1,0); \
    KRD(GL,3); GAPB(o[1]=__builtin_amdgcn_mfma_f32_32x32x16_bf16(PAF(2),VFR(6),o[1],0,0,0), C1,4); \
    GAPB(o[0]=__builtin_amdgcn_mfma_f32_32x32x16_bf16(PAF(3),VFR(3),o[0],0,0,0), C1,8); \
    GAPB(o[1]=__builtin_amdgcn_mfma_f32_32x32x16_bf16(PAF(3),VFR(7),o[1],0,0,0), C1,12); \
    }while(0)
  int t=1;
  for(;t+5<NT;t+=2){
    STEP(pB0,pB1,pA0,pA1,t,true,true,true);     WAIT_BAR(2); RESC(); ROT();
    STEP(pA0,pA1,pB0,pB1,t+1,true,true,true);   WAIT_BAR(2); RESC(); ROT();
  }
  #define ENDW(tt) do{ if((tt)+3<NT){WAIT_BAR(2);} else if((tt)+2<NT){WAIT_BAR(1);} else {WAIT_BAR(0);} }while(0)
  for(;t+1<NT;t+=2){
    STEP(pB0,pB1,pA0,pA1,t,(t+3<NT),(t+1<NT),(t+1<NT));       ENDW(t);   RESC(); ROT();
    STEP(pA0,pA1,pB0,pB1,t+1,(t+4<NT),(t+2<NT),(t+2<NT));     ENDW(t+1); RESC(); ROT();
  }
  STEP(pB0,pB1,pA0,pA1,NT-1,false,false,false); RESC();
  { float sacc=pB0[0]+pB0[1]; _Pragma("unroll") for(int r=2;r<16;++r)sacc+=pB0[r]; _Pragma("unroll") for(int r=0;r<16;++r)sacc+=pB1[r]; l_reg+=sacc;
    pw0=(u32x4){PKW(pB0,0),PKW(pB0,2),PKW(pB0,4),PKW(pB0,6)};pw1=(u32x4){PKW(pB0,8),PKW(pB0,10),PKW(pB0,12),PKW(pB0,14)};pw2=(u32x4){PKW(pB1,0),PKW(pB1,2),PKW(pB1,4),PKW(pB1,6)};pw3=(u32x4){PKW(pB1,8),PKW(pB1,10),PKW(pB1,12),PKW(pB1,14)};
    SBAR(); pv(o,vb0+sl_cur,PAF(0),PAF(1),PAF(2),PAF(3)); }
  #undef PKW
  #undef PAF
  #undef VFR
  #undef PIN
  #undef MX3
  #undef GAPA
  #undef GAPB
  #undef EX
  #undef VRD
  #undef KRD
  #undef STEP
  #undef ENDW
  {auto rr=__builtin_amdgcn_permlane32_swap(__float_as_uint(l_reg),__float_as_uint(l_reg),false,false);l_reg=__uint_as_float(rr[0])+__uint_as_float(rr[1]);}
  if(hi==0)wsf[32+r32]=l_reg;asm volatile("s_waitcnt lgkmcnt(0)":::"memory");
  float rli[16];
  #pragma unroll
  for(int r=0;r<16;++r)rli[r]=__builtin_amdgcn_rcpf(wsf[32+crow(r,hi)]);
  bf16*Ow=O+(rowbase+q0+wid*QBLK)*OP+h*D;
  { bf16*stg=(bf16*)(shm+LDS_OST)+wid*2048;
    #pragma unroll
    for(int r=0;r<16;++r){const int orow=crow(r,hi);
      #pragma unroll
      for(int d0=0;d0<2;++d0)stg[orow*64+d0*32+r32]=__float2bfloat16(o[d0][r]*rli[r]);}
    asm volatile("s_waitcnt lgkmcnt(0)":::"memory");
    #pragma unroll
    for(int i=0;i<4;++i){const int row=i*8+(lane>>3),ch=lane&7; const u32x4 v=*(const u32x4*)(stg+row*64+ch*8); ATTN_STORE16(Ow+(long)row*OP+ch*8,v);} }
  asm volatile("s_waitcnt lgkmcnt(0)\n\ts_barrier":::"memory");
  #undef DMA_K
  #undef DMA_V
  #undef CMASK
  #undef START
  #undef RESC
  #undef ROT
}
constexpr int ATTN_LDS_BYTES=LDS_BYTES;
#undef SBAR
#undef WAIT_BAR
}
typedef unsigned short us16;
#define GAS __attribute__((address_space(1)))
template <int CTRL> __device__ __forceinline__ int dpp_i(int v) { return __builtin_amdgcn_update_dpp(0, v, CTRL, 0xf, 0xf, true); }
template <int CTRL> __device__ __forceinline__ float dpp_f(float v) { return __builtin_bit_cast(float, __builtin_amdgcn_update_dpp(0, __builtin_bit_cast(int, v), CTRL, 0xf, 0xf, true)); }
__device__ __forceinline__ int row16_sum_i(int x) { x += dpp_i<0xB1>(x); x += dpp_i<0x4E>(x); x += dpp_i<0x141>(x); x += dpp_i<0x140>(x); return x; }
__device__ __forceinline__ float row16_sum_f(float x) { x += dpp_f<0xB1>(x); x += dpp_f<0x4E>(x); x += dpp_f<0x141>(x); x += dpp_f<0x140>(x); return x; }
__device__ __forceinline__ unsigned half32_sum_u(unsigned x) { int y = row16_sum_i((int)x); y += __shfl_xor(y, 16); return (unsigned)y; }
__device__ __forceinline__ unsigned half32_max_u(unsigned x) {
#pragma unroll
    for (int o = 1; o < 32; o <<= 1) { const unsigned y = (unsigned)__shfl_xor((int)x, o); x = x > y ? x : y; }
    return x; }
__device__ __forceinline__ unsigned half32_min_u(unsigned x) {
#pragma unroll
    for (int o = 1; o < 32; o <<= 1) { const unsigned y = (unsigned)__shfl_xor((int)x, o); x = x < y ? x : y; }
    return x; }
__device__ __forceinline__ int crow(int r, int hi) { return (r & 3) + 8 * (r >> 2) + 4 * hi; }
__device__ __forceinline__ constexpr int sig(int p) { return 16 * ((p & 7) >> 2) + 4 * (p >> 3) + (p & 3); }
__device__ __forceinline__ constexpr int sig_inv(int x) { return 8 * ((x >> 2) & 3) + 4 * (x >> 4) + (x & 3); }
__device__ __forceinline__ unsigned pkbf(float lo, float hi) { return pg8::cvt_pk_bf16(lo, hi); }

__device__ __forceinline__ void indexer_unit(const Args& A, LAS unsigned char* lds, int b, int qb, int wave, int lane) {
    { int t_ = wave * 64 + lane; asm volatile("" : "+v"(t_)); lane = t_ & 63; wave = __builtin_amdgcn_readfirstlane(t_ >> 6); }
    const unsigned char* ws = A.ws;
    const bf16* QI = (const bf16*)(ws + WS_QI); const bf16* KI = (const bf16*)(ws + WS_KI); const float* SM = (const float*)(ws + WS_SM);
    unsigned* MASK = (unsigned*)(ws + WS_MASK);
    const int r = lane & 31, hi = lane >> 5; const int t0 = qb * 32; const size_t tb = (size_t)b * SEQ;
    const int jn = qb + 1;
    bf16x8 af[4];
    { const int a = r >> 3, hq = (r >> 2) & 1, i = r & 3; const int qq = 2 * hq + (a >> 1), head = 4 * (a & 1) + i;
      const bf16* p = QI + (tb + t0 + 4 * wave + qq) * 512 + head * 64 + 8 * hi;
#pragma unroll
      for (int s = 0; s < 4; ++s) af[s] = *(const bf16x8*)(p + 16 * s); }
    float wq[2][8];
#pragma unroll
    for (int q2 = 0; q2 < 2; ++q2) { const float* p = SM + (tb + t0 + 4 * wave + 2 * hi + q2) * 16; const f32x4 w0 = *(const f32x4*)p, w1 = *(const f32x4*)(p + 4);
        wq[q2][0] = w0[0]; wq[q2][1] = w0[1]; wq[q2][2] = w0[2]; wq[q2][3] = w0[3]; wq[q2][4] = w1[0]; wq[q2][5] = w1[1]; wq[q2][6] = w1[2]; wq[q2][7] = w1[3]; }
    unsigned key[2][64];
    const int qloc0 = 4 * wave + 2 * hi;
    { unsigned lb = (unsigned)(uintptr_t)lds; asm volatile("" : "+v"(lb)); lds = (LAS unsigned char*)(uintptr_t)lb; }
    const int tid = wave * 64 + lane;
    const int nch = (jn + 7) >> 3;
    const GAS unsigned char* ksrc[4]; unsigned kdst[4];
#pragma unroll
    for (int k = 0; k < 4; ++k) { const int p = tid + 512 * k, row = p >> 3, c = p & 7; ksrc[k] = (const GAS unsigned char*)(KI + (tb + row) * 64 + 8 * c); kdst[k] = 8192 + row * 144 + 16 * c; }
    { v4u v[4];
#pragma unroll
      for (int k = 0; k < 4; ++k) { v[k] = *(const GAS v4u*)ksrc[k]; ksrc[k] += 256 * 128; }
#pragma unroll
      for (int k = 0; k < 4; ++k) *(LAS v4u*)(lds + kdst[k]) = v[k]; }
    __syncthreads();
    int jn1 = jn; asm volatile("" : "+s"(jn1));
    const unsigned boff = 8192 + r * 144 + 16 * hi;
#pragma unroll
    for (int c = 0; c < 8; ++c) {
        if (c < nch) {
            v4u v[4];
            if (c + 1 < nch) {
#pragma unroll
                for (int k = 0; k < 4; ++k) { v[k] = *(const GAS v4u*)ksrc[k]; ksrc[k] += 256 * 128; } }
            const LAS unsigned char* bp = lds + boff + (c & 1) * 36864;
#pragma unroll
            for (int jj = 0; jj < 8; ++jj) { const int j = 8 * c + jj;
                if (j < jn1) {
                    f32x16 cc = {};
#pragma unroll
                    for (int s = 0; s < 4; ++s) { const bf16x8 bfr = *(const LAS bf16x8*)(bp + jj * 32 * 144 + 32 * s); cc = __builtin_amdgcn_mfma_f32_32x32x16_bf16(af[s], bfr, cc, 0, 0, 0); }
#pragma unroll
                    for (int q2 = 0; q2 < 2; ++q2) { float sm = 0.f;
#pragma unroll
                        for (int hh = 0; hh < 8; ++hh) sm += wq[q2][hh] * __builtin_fmaxf(cc[8 * q2 + hh], 0.f);
                        sm += 0.0f;
                        const unsigned u = __builtin_bit_cast(unsigned, sm); unsigned k = (u >> 31) ? ~u : (u | 0x80000000u);
                        if (j == jn1 - 1 && r > qloc0 + q2) k = 0u;
                        key[q2][j] = k; }
                } else { key[0][j] = 0u; key[1][j] = 0u; }
            }
            if (c + 1 < nch) {
#pragma unroll
                for (int k = 0; k < 4; ++k) *(LAS v4u*)(lds + kdst[k] + ((c + 1) & 1) * 36864) = v[k]; }
            __syncthreads();
        } else {
#pragma unroll
            for (int jj = 0; jj < 8; ++jj) { key[0][8 * c + jj] = 0u; key[1][8 * c + jj] = 0u; }
        }
    }
    unsigned lo[2], hv[2], ksel[2];
#pragma unroll
    for (int q2 = 0; q2 < 2; ++q2) { unsigned mx = 0u, mn = 0xffffffffu;
#pragma unroll
        for (int j = 0; j < 64; ++j) { const unsigned k = key[q2][j]; mx = k > mx ? k : mx; const unsigned k1 = k - 1u; mn = k1 < mn ? k1 : mn; }
        hv[q2] = half32_max_u(mx); lo[q2] = half32_min_u(mn) + 1u; const int tq = t0 + qloc0 + q2; ksel[q2] = (unsigned)(tq + 1 < 256 ? tq + 1 : 256); if (tq + 1 <= 256) hv[q2] = lo[q2]; }
    int jn2 = jn; asm volatile("" : "+s"(jn2));
    while (__any((lo[0] < hv[0]) || (lo[1] < hv[1]))) {
        unsigned mid[2]; mid[0] = lo[0] + ((hv[0] - lo[0] + 1u) >> 1); mid[1] = lo[1] + ((hv[1] - lo[1] + 1u) >> 1);
        unsigned c0 = 0u, c1 = 0u;
#pragma unroll
        for (int jc = 0; jc < 8; ++jc) { if (8 * jc < jn2) {
#pragma unroll
            for (int j = 8 * jc; j < 8 * jc + 8; ++j) { c0 += (key[0][j] >= mid[0]) ? 1u : 0u; c1 += (key[1][j] >= mid[1]) ? 1u : 0u; } } }
        const unsigned tot = half32_sum_u(c0 | (c1 << 16));
        const unsigned t0c = tot & 0xffffu, t1c = tot >> 16;
        if (lo[0] < hv[0]) { if (t0c >= ksel[0]) lo[0] = mid[0]; else hv[0] = mid[0] - 1u; if (t0c == ksel[0]) hv[0] = mid[0]; }
        if (lo[1] < hv[1]) { if (t1c >= ksel[1]) lo[1] = mid[1]; else hv[1] = mid[1] - 1u; if (t1c == ksel[1]) hv[1] = mid[1]; }
    }
    unsigned need[2];
    { unsigned c0 = 0u, c1 = 0u;
#pragma unroll
      for (int j = 0; j < 64; ++j) { c0 += (key[0][j] > lo[0]) ? 1u : 0u; c1 += (key[1][j] > lo[1]) ? 1u : 0u; }
      const unsigned tot = half32_sum_u(c0 | (c1 << 16)); need[0] = ksel[0] - (tot & 0xffffu); need[1] = ksel[1] - (tot >> 16); }
    unsigned run[2] = {0u, 0u};
    const unsigned ltmask = (1u << r) - 1u;
    int jn3 = jn; asm volatile("" : "+s"(jn3));
    { unsigned lb = (unsigned)(uintptr_t)lds; asm volatile("" : "+v"(lb)); lds = (LAS unsigned char*)(uintptr_t)lb; }
    LAS unsigned* lm = (LAS unsigned*)lds + (wave * 4 + 2 * hi) * 64;
    lm[r] = 0u; lm[32 + r] = 0u; lm[64 + r] = 0u; lm[96 + r] = 0u;
#pragma unroll
    for (int j = 0; j < 64; ++j) {
        if (j < jn3) {
#pragma unroll
            for (int q2 = 0; q2 < 2; ++q2) { const unsigned k = key[q2][j]; const bool gt = k > lo[q2], eq = (k == lo[q2]);
                const unsigned long long be = __ballot(eq); const unsigned hm = hi ? (unsigned)(be >> 32) : (unsigned)be;
                const unsigned rank = run[q2] + (unsigned)__builtin_popcount(hm & ltmask); run[q2] += (unsigned)__builtin_popcount(hm);
                const bool sel = gt || (eq && rank < need[q2]);
                const unsigned long long bs = __ballot(sel); const unsigned sw = hi ? (unsigned)(bs >> 32) : (unsigned)bs;
                lm[q2 * 64 + j] = sw; }
            __builtin_amdgcn_sched_barrier(0);
        }
    }
#pragma unroll
    for (int q2 = 0; q2 < 2; ++q2) { unsigned* mp = MASK + (tb + t0 + qloc0 + q2) * 64; mp[r] = lm[q2 * 64 + r]; mp[32 + r] = lm[q2 * 64 + 32 + r]; }
    LDS_WAIT();
}
__device__ __forceinline__ void p6_indexer(const Args& A, LAS unsigned char* lds, int tid, int wave, int lane, int bid, int G) {
    for (int u = bid, it = 0; u < BATCH * 64; u += G, ++it) {
        int b, qb;
        if (G == 256) { b = bid >> 4; const int rr = bid & 15; qb = (it == 0) ? rr : (it == 1) ? 31 - rr : (it == 2) ? 32 + rr : 63 - rr; }
        else { b = u >> 6; qb = u & 63; }
        indexer_unit(A, lds, b, qb, wave, lane);
    }
}

constexpr int DN_X = 0, DN_KB = 69632, DN_QB = 87040, DN_L = 104448, DN_SC = 121856;
__device__ __forceinline__ void dn_prep_unit(const Args& A, LAS unsigned char* lds, int b, int n, int h, int tid, int wave, int lane) {
    asm volatile("" : "+v"(tid)); lane = tid & 63; wave = __builtin_amdgcn_readfirstlane(tid >> 6);
    unsigned char* ws = A.ws;
    const bf16* B4 = (const bf16*)(ws + WS_B4); const float* SM = (const float*)(ws + WS_SM);
    bf16* NEGW = (bf16*)A.out; bf16* QD = NEGW + (size_t)T * 512; bf16* KDT = QD + (size_t)T * 512; bf16* UB = KDT + (size_t)T * 512;
    bf16* AQK = (bf16*)(ws + WS_AQK); float* GL = (float*)(ws + WS_GL);
    const int cu = (b * 32 + n) * 4 + h; const size_t tokb = (size_t)b * SEQ + 64 * n;
    { unsigned lb = (unsigned)(uintptr_t)lds; asm volatile("" : "+v"(lb)); lds = (LAS unsigned char*)(uintptr_t)lb; }
    LAS float* sq = (LAS float*)(lds + DN_X);
    LAS float* Xm = (LAS float*)(lds + DN_X);
    LAS float* Um = (LAS float*)(lds + DN_QB);
    LAS float* Lm = (LAS float*)(lds + DN_L);
    LAS us16* kb = (LAS us16*)(lds + DN_KB); LAS us16* qbuf = (LAS us16*)(lds + DN_QB);
    LAS float* s_la = (LAS float*)(lds + DN_SC);
    LAS float* s_beta = s_la + 64; LAS float* s_eg = s_la + 128; LAS float* s_ekd = s_la + 192; LAS float* s_rn = s_la + 256;
    float val[64];
    const int grp = tid >> 7, c = tid & 127;
    if (grp < 3) {
        const int col = grp * 512 + h * 128 + c;
        const float cw0 = A.conv_w[0 * 1536 + col], cw1 = A.conv_w[1 * 1536 + col], cw2 = A.conv_w[2 * 1536 + col], cw3 = A.conv_w[3 * 1536 + col];
        const bf16* src = B4 + tokb * 2048 + col;
        const GAS bf16* sp = (const GAS bf16*)src - 3 * 2048;
#pragma unroll
        for (int hb = 0; hb < 2; ++hb) {
            unsigned short xin[35];
            if (hb == 0 && n == 0) { xin[0] = 0; xin[1] = 0; xin[2] = 0; } else { xin[0] = sp[0]; xin[1] = sp[2048]; xin[2] = sp[4096]; }
            { const GAS bf16* sq_ = sp + 3 * 2048;
#pragma unroll
              for (int i = 0; i < 32; ++i) { xin[3 + i] = *sq_; sq_ += 2048; asm volatile("" : "+v"(sq_)); } }
#pragma unroll
            for (int i = 0; i < 32; ++i) { const float y = cw0 * bf2f(xin[i]) + cw1 * bf2f(xin[i + 1]) + cw2 * bf2f(xin[i + 2]) + cw3 * bf2f(xin[i + 3]); val[32 * hb + i] = pg8::silu_f(y); }
            sp += 32 * 2048; asm volatile("" : "+v"(sp));
        }
        if (grp < 2) {
#pragma unroll
            for (int i = 0; i < 64; ++i) sq[(grp * 64 + i) * 128 + c] = val[i] * val[i];
        }
    } else {
#pragma unroll
        for (int i = 0; i < 64; ++i) val[i] = 0.f;
        if (c < 64) { const float* sm = SM + (tokb + c) * 16; const float ba = sm[8 + h], bb = sm[12 + h];
            const float z = ba + A.dt_bias[h]; const float sp = (z > 20.f) ? z : log1pf(__expf(z));
            s_la[c] = -__expf(A.a_log[h]) * sp; s_beta[c] = 1.0f / (1.0f + __expf(-bb)); }
    }
    __syncthreads();
    { const int row = tid >> 2, part = tid & 3; const LAS float* p = sq + row * 128 + 32 * part; const int rot = row + 8 * part; float s = 0.f;
#pragma unroll
      for (int i = 0; i < 32; ++i) s += p[(i + rot) & 31];
      s += dpp_f<0xB1>(s); s += dpp_f<0x4E>(s);
      if (part == 0) s_rn[row] = 1.0f / sqrtf(s + RMS_EPS); }
    if (wave == 7) {
        float g = s_la[lane];
#pragma unroll
        for (int o = 1; o < 64; o <<= 1) { const float t = __shfl_up(g, o); if (lane >= o) g += t; }
        const float g63 = __shfl(g, 63);
        s_la[lane] = g; s_eg[lane] = __expf(g); s_ekd[lane] = __expf(g63 - g);
        if (lane == 0) GL[cu] = __expf(g63);
    }
    __syncthreads();
    if (grp == 0) {
#pragma unroll
        for (int i = 0; i < 64; ++i) { val[i] *= s_rn[i] * 0.08838834764831845f; qbuf[i * 136 + c] = (us16)f2bf(val[i]); }
        GAS bf16* qd = (GAS bf16*)(QD + tokb * 512 + h * 128 + 32 * (c >> 5) + sig_inv(c & 31));
#pragma unroll
        for (int i = 0; i < 64; ++i) { *qd = (bf16)f2bf(val[i] * s_eg[i]); qd += 512; asm volatile("" : "+v"(qd)); }
    } else if (grp == 1) {
#pragma unroll
        for (int i = 0; i < 64; ++i) { val[i] *= s_rn[64 + i]; kb[i * 136 + c] = (us16)f2bf(val[i]); }
        GAS bf16* kd = (GAS bf16*)(KDT + ((size_t)cu * 128 + c) * 64);
#pragma unroll
        for (int p8 = 0; p8 < 8; ++p8) { v4u o;
#define KDV(pp) (val[32 * ((8 * p8 + (pp)) >> 5) + sig((8 * p8 + (pp)) & 31)] * s_ekd[32 * ((8 * p8 + (pp)) >> 5) + sig((8 * p8 + (pp)) & 31)])
            o.x = pk2(KDV(0), KDV(1)); o.y = pk2(KDV(2), KDV(3)); o.z = pk2(KDV(4), KDV(5)); o.w = pk2(KDV(6), KDV(7));
#undef KDV
            *(GAS v4u*)(kd + 8 * p8) = o; }
    }
    __syncthreads();
    if (wave < 6) {
        const int tI = (wave % 3) >= 1 ? 1 : 0, tJ = (wave % 3) == 2 ? 1 : 0; const bool isq = wave >= 3;
        const int r = lane & 31, hi = lane >> 5;
        const LAS us16* ap = (isq ? qbuf : kb) + (32 * tI + r) * 136 + 8 * hi; const LAS us16* bp = kb + (32 * tJ + r) * 136 + 8 * hi;
        f32x16 cacc = {};
#pragma unroll
        for (int s = 0; s < 8; ++s) { const bf16x8 a = *(const LAS bf16x8*)(ap + 16 * s), bb = *(const LAS bf16x8*)(bp + 16 * s); cacc = __builtin_amdgcn_mfma_f32_32x32x16_bf16(a, bb, cacc, 0, 0, 0);
            if (s & 1) __builtin_amdgcn_sched_barrier(0); }
        const int j = 32 * tJ + r; const float gj = s_la[j];
        GAS bf16* aq = (GAS bf16*)(AQK + (size_t)cu * 4096 + (32 * tI + 4 * hi) * 64 + 32 * tJ + sig_inv(r)); asm volatile("" : "+v"(aq));
#pragma unroll
        for (int reg = 0; reg < 16; ++reg) { const int i = 32 * tI + crow(reg, hi); const float gi = s_la[i]; const float cv = cacc[reg];
            if (!isq) { const bool m = j < i; const float v = m ? s_beta[i] * cv * __expf(m ? gi - gj : 0.f) : 0.f; Lm[i * 68 + j] = v; }
            else { const bool m = j <= i; const float v = m ? cv * __expf(m ? gi - gj : 0.f) : 0.f; aq[((reg & 3) + 8 * (reg >> 2)) * 64] = (bf16)f2bf(v); } }
    } else if (wave == 6) {
        for (int e = lane; e < 32 * 32 / 8; e += 64) { const int i = e >> 2, ch = e & 3; *(GAS v4u*)(AQK + (size_t)cu * 4096 + i * 64 + 32 + 8 * ch) = (v4u){0u, 0u, 0u, 0u}; }
    }
    __syncthreads();
    const bool colthr = (grp == 1 || grp == 2); const int xcol = tid - 128;
    if (colthr) {
#pragma unroll
        for (int i = 0; i < 64; ++i) val[i] *= (grp == 1) ? s_beta[i] * s_eg[i] : s_beta[i];
    }
    GAS bf16* outp = (GAS bf16*)((grp == 1) ? (NEGW + tokb * 512 + h * 128 + 32 * (c >> 5) + sig_inv(c & 31)) : (UB + tokb * 512 + h * 128 + c));
    const float osign = (grp == 1) ? -1.0f : 1.0f;
#pragma unroll
    for (int I = 0; I < 4; ++I) {
        if (I > 0) {
            const int fr = lane & 15, g = lane >> 4;
#pragma unroll
            for (int ct = 0; ct < 2; ++ct) { const int c16 = 2 * wave + ct; f32x4 acc = (f32x4){0.f, 0.f, 0.f, 0.f};
#pragma unroll
                for (int kk = 0; kk < 4 * I; ++kk) { const float a = Lm[(16 * I + fr) * 68 + 4 * kk + g]; const float bq = Xm[(4 * kk + g) * 272 + 16 * c16 + fr];
                    acc = __builtin_amdgcn_mfma_f32_16x16x4f32(a, bq, acc, 0, 0, 0); }
#pragma unroll
                for (int rho = 0; rho < 4; ++rho) Um[(4 * g + rho) * 272 + 16 * c16 + fr] = acc[rho]; }
            __syncthreads();
        }
        if (colthr) {
            if (I > 0) {
#pragma unroll
                for (int r = 0; r < 16; ++r) val[16 * I + r] -= Um[r * 272 + xcol]; }
#pragma unroll
            for (int r = 1; r < 16; ++r) { const int i = 16 * I + r; float a0 = 0.f, a1 = 0.f, a2 = 0.f, a3 = 0.f;
#pragma unroll
                for (int m4 = 0; m4 < (r + 3) / 4; ++m4) { const f32x4 l4 = *(const LAS f32x4*)(Lm + i * 68 + 16 * I + 4 * m4);
                    a0 += l4[0] * val[16 * I + 4 * m4];
                    if (4 * m4 + 1 < r) a1 += l4[1] * val[16 * I + 4 * m4 + 1];
                    if (4 * m4 + 2 < r) a2 += l4[2] * val[16 * I + 4 * m4 + 2];
                    if (4 * m4 + 3 < r) a3 += l4[3] * val[16 * I + 4 * m4 + 3]; }
                val[i] -= (a0 + a1) + (a2 + a3); }
#pragma unroll
            for (int r = 0; r < 16; ++r) { *outp = (bf16)f2bf(osign * val[16 * I + r]); outp += 512; asm volatile("" : "+v"(outp)); }
            if (I < 3) {
#pragma unroll
                for (int r = 0; r < 16; ++r) Xm[(16 * I + r) * 272 + xcol] = val[16 * I + r]; }
        }
        if (I < 3) __syncthreads();
    }
    __syncthreads();
}
__device__ __forceinline__ void p6_dn_prep(const Args& A, LAS unsigned char* lds, int tid, int wave, int lane, int bid, int G) {
    for (int u = bid; u < BATCH * 32 * 4; u += G) { const int h = u & 3, n = (u >> 2) & 31, b = u >> 7; dn_prep_unit(A, lds, b, n, h, tid, wave, lane); }
}

constexpr int SC_W = 0, SC_QD = 17408, SC_AQK = 34816, SC_KDT = 44032, SC_U = 62464, SC_BUF = 66560, SC_XS = 2 * SC_BUF;
__device__ __forceinline__ void dn_scan_unit(const Args& A, LAS unsigned char* lds, int b, int h, int q4, int tid, int wave, int lane) {
    asm volatile("" : "+v"(tid)); lane = tid & 63; wave = __builtin_amdgcn_readfirstlane(tid >> 6);
    unsigned char* ws = A.ws;
    const bf16* NEGW = (const bf16*)A.out; const bf16* QD = NEGW + (size_t)T * 512; const bf16* KDT = QD + (size_t)T * 512; const bf16* UB = KDT + (size_t)T * 512;
    const bf16* AQK = (const bf16*)(ws + WS_AQK); const float* GL = (const float*)(ws + WS_GL);
    bf16* DN = (bf16*)(ws + WS_QI); float* SSQ = (float*)(ws + WS_SM);
    { unsigned lb = (unsigned)(uintptr_t)lds; asm volatile("" : "+v"(lb)); lds = (LAS unsigned char*)(uintptr_t)lb; }
    const size_t tok0 = (size_t)b * SEQ; const int cu0 = (b * 32) * 4 + h;
    if (wave >= 2) {
        const int tl = tid - 128;
        const GAS unsigned char* src[10]; unsigned dst[10], stride[10];
#pragma unroll
        for (int k = 0; k < 10; ++k) { const int p = tl + 384 * k;
            if (p < 1024) { const int row = p >> 4, c = p & 15; src[k] = (const GAS unsigned char*)(NEGW + (tok0 + row) * 512 + h * 128 + 8 * c); dst[k] = SC_W + row * 272 + 16 * c; stride[k] = 64 * 512 * 2; }
            else if (p < 2048) { const int pp = p - 1024, row = pp >> 4, c = pp & 15; src[k] = (const GAS unsigned char*)(QD + (tok0 + row) * 512 + h * 128 + 8 * c); dst[k] = SC_QD + row * 272 + 16 * c; stride[k] = 64 * 512 * 2; }
            else if (p < 2560) { const int pp = p - 2048, row = pp >> 3, c = pp & 7; src[k] = (const GAS unsigned char*)(AQK + (size_t)cu0 * 4096 + row * 64 + 8 * c); dst[k] = SC_AQK + row * 144 + 16 * c; stride[k] = 4 * 4096 * 2; }
            else if (p < 3584) { const int pp = p - 2560, row = pp >> 3, c = pp & 7; src[k] = (const GAS unsigned char*)(KDT + ((size_t)cu0 * 128 + row) * 64 + 8 * c); dst[k] = SC_KDT + row * 144 + 16 * c; stride[k] = 4 * 128 * 64 * 2; }
            else { const int pp = p - 3584, row = pp >> 2, c = pp & 3; src[k] = (const GAS unsigned char*)(UB + (tok0 + row) * 512 + h * 128 + 32 * q4 + 8 * c); dst[k] = SC_U + row * 64 + 16 * c; stride[k] = 64 * 512 * 2; } }
        for (int n = 0; n <= 32; ++n) {
            if (n < 32) { v4u v[10];
#pragma unroll
                for (int k = 0; k < 10; ++k) { v[k] = *(const GAS v4u*)src[k]; src[k] += stride[k]; }
                LAS unsigned char* bufp = lds + (n & 1) * SC_BUF;
#pragma unroll
                for (int k = 0; k < 10; ++k) *(LAS v4u*)(bufp + dst[k]) = v[k]; }
            __syncthreads();
        }
    } else {
        const int fr = lane & 15, g = lane >> 4, cw = wave; const int dvl = 16 * cw + fr;
        f32x4 S[8];
#pragma unroll
        for (int a = 0; a < 8; ++a) S[a] = (f32x4){0.f, 0.f, 0.f, 0.f};
        LAS float* xs = (LAS float*)(lds + SC_XS);
        float mys[16];
#pragma unroll
        for (int i = 0; i < 16; ++i) mys[i] = 0.f;
        __syncthreads();
        for (int n = 0; n < 32; ++n) {
            const LAS unsigned char* bufp = lds + (n & 1) * SC_BUF;
            const int cu = cu0 + 4 * n; const size_t tokb = tok0 + 64 * n;
            const float gl = GL[cu];
            if (n > 0 && cw == 0) {
                const LAS float* xp = xs + ((n - 1) & 1) * 64;
#pragma unroll
                for (int m = 0; m < 4; ++m)
#pragma unroll
                    for (int rho = 0; rho < 4; ++rho) { const int tk = 16 * m + 4 * g + rho; const float q = mys[4 * m + rho] + xp[tk]; if (fr == 0) SSQ[(tokb - 64 + tk) * 16 + h * 4 + q4] = q; }
            }
            bf16x8 Bs[4];
#pragma unroll
            for (int s = 0; s < 4; ++s) { v4u w; w.x = pkbf(S[2 * s][0], S[2 * s][1]); w.y = pkbf(S[2 * s][2], S[2 * s][3]); w.z = pkbf(S[2 * s + 1][0], S[2 * s + 1][1]); w.w = pkbf(S[2 * s + 1][2], S[2 * s + 1][3]); Bs[s] = __builtin_bit_cast(bf16x8, w); }
            f32x4 dl[4], ot[4];
#pragma unroll
            for (int m = 0; m < 4; ++m) {
                const LAS us16* up = (const LAS us16*)(bufp + SC_U + (16 * m + 4 * g) * 64) + dvl;
                f32x4 d = (f32x4){bf2f(up[0]), bf2f(up[32]), bf2f(up[64]), bf2f(up[96])};
                f32x4 o = (f32x4){0.f, 0.f, 0.f, 0.f};
                const LAS unsigned char* wp = bufp + SC_W + (16 * m + fr) * 272 + 16 * g; const LAS unsigned char* qp = bufp + SC_QD + (16 * m + fr) * 272 + 16 * g;
#pragma unroll
                for (int s = 0; s < 4; ++s) { const bf16x8 wa = *(const LAS bf16x8*)(wp + 64 * s), qa = *(const LAS bf16x8*)(qp + 64 * s);
                    d = __builtin_amdgcn_mfma_f32_16x16x32_bf16(wa, Bs[s], d, 0, 0, 0); o = __builtin_amdgcn_mfma_f32_16x16x32_bf16(qa, Bs[s], o, 0, 0, 0); }
                dl[m] = d; ot[m] = o;
            }
            bf16x8 Bd[2];
#pragma unroll
            for (int s2 = 0; s2 < 2; ++s2) { v4u w; w.x = pkbf(dl[2 * s2][0], dl[2 * s2][1]); w.y = pkbf(dl[2 * s2][2], dl[2 * s2][3]); w.z = pkbf(dl[2 * s2 + 1][0], dl[2 * s2 + 1][1]); w.w = pkbf(dl[2 * s2 + 1][2], dl[2 * s2 + 1][3]); Bd[s2] = __builtin_bit_cast(bf16x8, w); }
#pragma unroll
            for (int m = 0; m < 4; ++m) { const LAS unsigned char* ap = bufp + SC_AQK + (16 * m + fr) * 144 + 16 * g;
#pragma unroll
                for (int s2 = 0; s2 < 2; ++s2) { const bf16x8 aa = *(const LAS bf16x8*)(ap + 64 * s2); ot[m] = __builtin_amdgcn_mfma_f32_16x16x32_bf16(aa, Bd[s2], ot[m], 0, 0, 0); } }
#pragma unroll
            for (int a = 0; a < 8; ++a) { const LAS unsigned char* kp = bufp + SC_KDT + (16 * a + fr) * 144 + 16 * g; f32x4 sn = S[a] * gl;
#pragma unroll
                for (int s2 = 0; s2 < 2; ++s2) { const bf16x8 ka = *(const LAS bf16x8*)(kp + 64 * s2); sn = __builtin_amdgcn_mfma_f32_16x16x32_bf16(ka, Bd[s2], sn, 0, 0, 0); }
                S[a] = sn; }
            bf16* dnp = DN + (tokb + 4 * g) * 512 + h * 128 + 32 * q4 + dvl;
#pragma unroll
            for (int m = 0; m < 4; ++m)
#pragma unroll
                for (int rho = 0; rho < 4; ++rho) { const float v = ot[m][rho]; dnp[(size_t)(16 * m + rho) * 512] = (bf16)f2bf(v); const float vb = bf2f((unsigned short)f2bf(v)); mys[4 * m + rho] = row16_sum_f(vb * vb); }
            if (cw == 1 && fr == 0) { LAS float* xp = xs + (n & 1) * 64;
#pragma unroll
                for (int m = 0; m < 4; ++m)
#pragma unroll
                    for (int rho = 0; rho < 4; ++rho) xp[16 * m + 4 * g + rho] = mys[4 * m + rho]; }
            __syncthreads();
        }
        if (cw == 0) { const LAS float* xp = xs + 64; const size_t tokb = tok0 + 64 * 31;
#pragma unroll
            for (int m = 0; m < 4; ++m)
#pragma unroll
                for (int rho = 0; rho < 4; ++rho) { const int tk = 16 * m + 4 * g + rho; const float q = mys[4 * m + rho] + xp[tk]; if (fr == 0) SSQ[(tokb + tk) * 16 + h * 4 + q4] = q; } }
    }
    __syncthreads();
}
__device__ __forceinline__ void p7c_dn_finalize(const Args& A, int wave, int lane, int bid, int G) {
    const unsigned char* ws = A.ws;
    const bf16* DN = (const bf16*)(ws + WS_QI); const float* SSQ = (const float*)(ws + WS_SM); const bf16* B4 = (const bf16*)(ws + WS_B4); bf16* MIX = (bf16*)(A.ws + WS_U);
    const int gw = bid * NWAVES + wave, NGW = G * NWAVES; const int hd = lane >> 4;
    const f32x4 g0 = *(const f32x4*)(A.dn_g + 8 * (lane & 15)), g1 = *(const f32x4*)(A.dn_g + 8 * (lane & 15) + 4);
    for (int t = gw; t < T; t += NGW) {
        const f32x4 sq = *(const f32x4*)(SSQ + (size_t)t * 16 + 4 * hd);
        const float rinv = 1.0f / sqrtf(((sq[0] + sq[1]) + (sq[2] + sq[3])) * (1.0f / 128.0f) + RMS_EPS);
        const v4u dv = *(const v4u*)(DN + (size_t)t * 512 + 8 * lane), zv = *(const v4u*)(B4 + (size_t)t * 2048 + 1536 + 8 * lane);
        v4u o;
#define FIN(w, ga, gb) pk2(bf2f((unsigned short)(dv.w & 0xffffu)) * rinv * (ga) * pg8::silu_f(bf2f((unsigned short)(zv.w & 0xffffu))), bf2f((unsigned short)(dv.w >> 16)) * rinv * (gb) * pg8::silu_f(bf2f((unsigned short)(zv.w >> 16))))
        o.x = FIN(x, g0[0], g0[1]); o.y = FIN(y, g0[2], g0[3]); o.z = FIN(z, g1[0], g1[1]); o.w = FIN(w, g1[2], g1[3]);
#undef FIN
        *(v4u*)(MIX + (size_t)t * 1024 + 512 + 8 * lane) = o;
    }
}
__device__ __forceinline__ void p7_mixer(const Args& A, LAS unsigned char* lds, int tid, int wave, int lane, int bid, int G, int mode) {
    if (mode != 4) for (int u = bid; u < 256; u += G) { const int q4 = (u >> 3) & 3, bh = (u & 7) + 8 * (u >> 5); dn_scan_unit(A, lds, bh >> 2, bh & 3, q4, tid, wave, lane); }
    if (mode == 3) return;
    unsigned* ctr = (unsigned*)(A.ws + WS_CTL) + CW_QUEUE * (mode == 4 ? 2 : mode);
    LAS unsigned* slot = (LAS unsigned*)(lds + 2048);
    for (;;) {
        if (tid == 0) slot[0] = atomicAdd(ctr, 1u);
        __syncthreads();
        const unsigned u = slot[0];
        __syncthreads();
        if (u >= (unsigned)(BATCH * 8 * 8)) break;
        const int qb = 7 - (int)(u >> 7), bh = (int)(u & 127);
        attn_body::attn_unit<8>(bh >> 3, bh & 7, qb, (const attn_body::bf16*)(A.ws + WS_Q), (const attn_body::bf16*)(A.ws + WS_K), (const attn_body::bf16*)(A.ws + WS_VT),
                                (attn_body::bf16*)(A.ws + WS_U), (const unsigned*)(A.ws + WS_MASK), (char*)lds);
    }
}
constexpr int LDS_BYTES = 147456;
#ifndef MIXER
#define MIXER 1
#endif

#ifndef DUP
#define DUP 0
#endif
#ifndef BARSEL
#define BARSEL 0
#endif
#define SEAM(k) do { if ((BARSEL >> (k)) & 1) grid.sync(); else xcd_barrier(bar); } while (0)
__global__ void __launch_bounds__(NTHREADS, 2) fwd_megakernel(Args A) {
    extern __shared__ __attribute__((aligned(16))) unsigned char lds_raw[];
    cg::grid_group grid = cg::this_grid();
    LAS unsigned char* lds = (LAS unsigned char*)lds_raw;
    const int tid = threadIdx.x, lane = tid & 63, wave = __builtin_amdgcn_readfirstlane(tid >> 6);
    const int bid = blockIdx.x, G = gridDim.x;
    unsigned char* ws = A.ws;
    float* mod = (float*)(ws + WS_MOD);
    bf16* U = (bf16*)(ws + WS_U); bf16* H = (bf16*)(ws + WS_H); float* X = (float*)(ws + WS_X); float* Y = A.out;
    bf16* MIX = U;
    XcdBarrier bar{(unsigned*)(ws + WS_CTL) + 4096, 0u, (unsigned)G};

    if (bid == 0 && tid < 64) __hip_atomic_store((unsigned*)(ws + WS_CTL) + (tid == 0 ? 4096 : 64 * tid), 0u, __ATOMIC_RELAXED, __HIP_MEMORY_SCOPE_AGENT);
    p0_mod(A, lds, tid, wave, lane, bid, G);
    p0_weights(A, lds, wave, lane, bid, G);
    p0_rope(A, tid, bid, G);
    grid.sync();
    p_modulate_rows(A.x, U, mod, 0 * D, 1 * D, wave, lane, bid, G);
    SEAM(1);
    { pg8::Gemm g{U, (const bf16*)(ws + WS_W13A), T, 2 * FF, D}; pg8::StaticOrder S; S.init(T, 2 * FF, G, bid);
      pg8::EpiSwiGLU E{H, FF}; pg8::gemm_phase<pg8::EpiSwiGLU, pg8::StaticOrder, true, true>(lds, g, S, E);
#if DUP == 2
      grid.sync(); pg8::gemm_phase<pg8::EpiSwiGLU, pg8::StaticOrder, true, true>(lds, g, S, E);
#endif
    }
    SEAM(2);
    { pg8::Gemm g{H, (const bf16*)(ws + WS_W2A), T, D, FF}; pg8::StaticOrder S; S.init(T, D, G, bid);
      pg8::EpiResid E{A.x, Y, mod + 2 * D, NMOD, 0.5f, ALPHA}; pg8::gemm_phase<pg8::EpiResid, pg8::StaticOrder, true, true>(lds, g, S, E);
#if DUP == 3
      grid.sync(); pg8::gemm_phase<pg8::EpiResid, pg8::StaticOrder, true, true>(lds, g, S, E);
#endif
    }
    SEAM(3);
    p_ln_rows(Y, X, U, A.ln1g, A.ln1b, mod, 3 * D, 4 * D, wave, lane, bid, G);
#if DUP == 4
    grid.sync(); p_ln_rows(Y, X, U, A.ln1g, A.ln1b, mod, 3 * D, 4 * D, wave, lane, bid, G);
#endif
    SEAM(4);
#if MIXER
    { pg8::Gemm g{U, (const bf16*)(ws + WS_WIN), T, NINP, D}; pg8::StaticOrder S; S.init(T, NINP, G, bid);
      pg8::EpiInProj E{(bf16*)(ws + WS_Q), (bf16*)(ws + WS_QI), (bf16*)(ws + WS_K), (bf16*)(ws + WS_KI), (bf16*)(ws + WS_VT), (bf16*)(ws + WS_B4), (float*)(ws + WS_SM),
                       (const float*)(ws + WS_COS), (const float*)(ws + WS_SIN), QSCALE, 0.04419417382415922f};
      pg8::gemm_phase<pg8::EpiInProj, pg8::StaticOrder, true, true>(lds, g, S, E);
#if DUP == 5
      grid.sync(); pg8::gemm_phase<pg8::EpiInProj, pg8::StaticOrder, true, true>(lds, g, S, E);
#endif
    }
    SEAM(5);
    p6_indexer(A, lds, tid, wave, lane, bid, G);
    __syncthreads();
#if DUP == 61
    grid.sync(); p6_indexer(A, lds, tid, wave, lane, bid, G); __syncthreads();
#endif
    p6_dn_prep(A, lds, tid, wave, lane, bid, G);
#if DUP == 62
    grid.sync(); p6_dn_prep(A, lds, tid, wave, lane, bid, G);
#endif
    SEAM(6);
    p7_mixer(A, lds, tid, wave, lane, bid, G, 1);
#if DUP == 7
    grid.sync(); p7_mixer(A, lds, tid, wave, lane, bid, G, 2);
#endif
#if DUP == 71
    grid.sync(); p7_mixer(A, lds, tid, wave, lane, bid, G, 3);
#endif
#if DUP == 72
    grid.sync(); p7_mixer(A, lds, tid, wave, lane, bid, G, 4);
#endif
    SEAM(7);
    p7c_dn_finalize(A, wave, lane, bid, G);
    SEAM(13);
#else
    for (size_t i = (size_t)bid * NTHREADS + tid; i < (size_t)T * D / 8; i += (size_t)G * NTHREADS) ((v4u*)MIX)[i] = (v4u){0u, 0u, 0u, 0u};
    SEAM(8);
#endif
    { pg8::Gemm g{MIX, (const bf16*)(ws + WS_WOUT), T, D, D}; pg8::StaticOrder S; S.init(T, D, G, bid);
      pg8::EpiResid E{X, Y, mod + 5 * D, NMOD, 1.0f, ALPHA}; pg8::gemm_phase<pg8::EpiResid, pg8::StaticOrder, true, true>(lds, g, S, E); }
    SEAM(9);
    p_ln_rows(Y, X, U, A.ln2g, A.ln2b, mod, 6 * D, 7 * D, wave, lane, bid, G);
    SEAM(10);
    { pg8::Gemm g{U, (const bf16*)(ws + WS_W13B), T, 2 * FF, D}; pg8::StaticOrder S; S.init(T, 2 * FF, G, bid);
      pg8::EpiSwiGLU E{H, FF}; pg8::gemm_phase<pg8::EpiSwiGLU, pg8::StaticOrder, true, true>(lds, g, S, E); }
    SEAM(11);
    { pg8::Gemm g{H, (const bf16*)(ws + WS_W2B), T, D, FF}; pg8::StaticOrder S; S.init(T, D, G, bid);
      pg8::EpiResid E{X, Y, mod + 8 * D, NMOD, 0.5f, ALPHA}; pg8::gemm_phase<pg8::EpiResid, pg8::StaticOrder, true, true>(lds, g, S, E); }
    SEAM(12);
    p_ln_rows(Y, Y, nullptr, A.ln3g, A.ln3b, mod, 0, 0, wave, lane, bid, G);
}

extern "C" void kernel_launch(void* const* d_in, const int* in_sizes, int n_in, void* d_out, int out_size, void* d_ws, size_t ws_size, hipStream_t stream) {
    static int grid_blocks = 0;
    if (grid_blocks == 0) {
        if (n_in != 23 || out_size != T * D || ws_size < WS_END) { fprintf(stderr, "kernel_launch: unexpected shapes (n_in %d out %d ws %zu)\n", n_in, out_size, ws_size); grid_blocks = -1; return; }
        int dev = 0, cus = 0, per_cu = 0;
        (void)hipGetDevice(&dev); (void)hipDeviceGetAttribute(&cus, hipDeviceAttributeMultiprocessorCount, dev);
        if (hipFuncSetAttribute((const void*)fwd_megakernel, hipFuncAttributeMaxDynamicSharedMemorySize, LDS_BYTES) != hipSuccess) { fprintf(stderr, "kernel_launch: hipFuncSetAttribute failed\n"); grid_blocks = -1; return; }
        if (hipOccupancyMaxActiveBlocksPerMultiprocessor(&per_cu, (const void*)fwd_megakernel, NTHREADS, LDS_BYTES) != hipSuccess || per_cu < 1) { fprintf(stderr, "kernel_launch: occupancy query says %d\n", per_cu); per_cu = 1; }
        (void)hipGetLastError();
        grid_blocks = cus * 1;
        fprintf(stderr, "kernel_launch: cus %d per_cu %d grid %d\n", cus, per_cu, grid_blocks);
    }
    if (grid_blocks < 0) return;
    (void)hipMemsetAsync((char*)d_ws + WS_CTL, 0, CTL_ZERO_BYTES, stream);
    Args a{};
    const float** fp = (const float**)&a;
    a.x = (const float*)d_in[0]; a.c = (const float*)d_in[1]; a.pos = (const int*)d_in[2]; a.w_ada = (const float*)d_in[3]; a.b_ada = (const float*)d_in[4];
    a.f1w1 = (const float*)d_in[5]; a.f1w3 = (const float*)d_in[6]; a.f1w2 = (const float*)d_in[7]; a.ln1g = (const float*)d_in[8]; a.ln1b = (const float*)d_in[9];
    a.w_in = (const float*)d_in[10]; a.conv_w = (const float*)d_in[11]; a.a_log = (const float*)d_in[12]; a.dt_bias = (const float*)d_in[13]; a.dn_g = (const float*)d_in[14];
    a.w_out = (const float*)d_in[15]; a.ln2g = (const float*)d_in[16]; a.ln2b = (const float*)d_in[17]; a.f2w1 = (const float*)d_in[18]; a.f2w3 = (const float*)d_in[19];
    a.f2w2 = (const float*)d_in[20]; a.ln3g = (const float*)d_in[21]; a.ln3b = (const float*)d_in[22];
    (void)fp;
    a.out = (float*)d_out; a.ws = (unsigned char*)d_ws;
    void* args[] = {&a};
    hipError_t e = hipLaunchCooperativeKernel((const void*)fwd_megakernel, dim3(grid_blocks), dim3(NTHREADS), args, LDS_BYTES, stream);
    if (e != hipSuccess) fprintf(stderr, "kernel_launch: cooperative launch failed: %s (grid %d)\n", hipGetErrorString(e), grid_blocks);
}
```
